# Optimizing an MI355X kernel written in HIP

```python
import math
import jax, jax.numpy as jnp
from jax import lax
import numpy as np

D_MODEL = 1024
BATCH = 4
SEQ = 4096
DEPTH = 1

ATTN_GROUPS = ((128, 1), (512, 4), (2048, 16))
N_ATTN_GROUPS = len(ATTN_GROUPS)
ATTN_HEADS = 8
ATTN_HEAD_DIM = D_MODEL // 16
ATTN_GROUP_WIDTH = ATTN_HEADS * ATTN_HEAD_DIM
ATTN_QKV_WIDTH = N_ATTN_GROUPS * ATTN_GROUP_WIDTH
RET_HEADS = 4
RET_KEY_DIM = D_MODEL // 8
RET_VALUE_DIM = 2 * RET_KEY_DIM
RET_QK_WIDTH = RET_HEADS * RET_KEY_DIM
RET_V_WIDTH = RET_HEADS * RET_VALUE_DIM
RET_CHUNK = 128
N_BRANCHES = 2
IN_SPLITS = (ATTN_QKV_WIDTH, ATTN_QKV_WIDTH, ATTN_QKV_WIDTH,
             RET_QK_WIDTH, RET_QK_WIDTH, RET_V_WIDTH, RET_V_WIDTH,
             D_MODEL, D_MODEL)
IN_WIDTH = sum(IN_SPLITS)
N_EXPERT_GROUPS = 4
EXPERTS_PER_GROUP = 8
N_EXPERTS = N_EXPERT_GROUPS * EXPERTS_PER_GROUP
TOP_K_IN_GROUP = 2
EXPERT_FF = D_MODEL // 2
EPS = 1e-6

kernel_name = "hybrid_dilated_attn_retention_hmoe_block"


def rms_norm(x, g):
    xf = x.astype(jnp.float32)
    y = xf * lax.rsqrt(jnp.mean(xf * xf, axis=-1, keepdims=True) + EPS)
    return (y * g.astype(jnp.float32)).astype(x.dtype)


def alibi_slopes(n):
    return jnp.exp2(-8.0 * jnp.arange(1, n + 1, dtype=jnp.float32) / n)


def dilated_window_attention(q, k, v, slopes, window, dilation):
    B, S, H, Dh = q.shape
    n_back = window // dilation
    blk = n_back
    L = S // dilation
    nb = -(-L // blk)
    Lp = nb * blk

    def to_blocks(t):
        t = t.reshape(B, L, dilation, H, Dh)
        t = jnp.pad(t, ((0, 0), (0, Lp - L), (0, 0), (0, 0), (0, 0)))
        t = t.reshape(B, nb, blk, dilation, H, Dh)
        return t.transpose(0, 3, 4, 1, 2, 5)

    def with_prev(t):
        prev = jnp.pad(t, ((0, 0), (0, 0), (0, 0), (1, 0), (0, 0), (0, 0)))[:, :, :, :-1]
        return jnp.concatenate([prev, t], axis=4)

    qb, kb, vb = to_blocks(q), to_blocks(k), to_blocks(v)
    kk, vv = with_prev(kb), with_prev(vb)
    s = jnp.einsum('brhnqc,brhnkc->brhnqk', qb, kk,
                   preferred_element_type=jnp.float32) * (Dh ** -0.5)
    qi = jnp.arange(blk)[:, None]
    kj = jnp.arange(2 * blk)[None, :]
    rel = qi + blk - kj
    blk_idx = jnp.arange(nb)[:, None, None]
    valid = (rel >= 0) & (rel <= n_back) & ((blk_idx > 0) | (kj >= blk))
    bias = -slopes[:, None, None, None] * (rel * dilation).astype(jnp.float32)
    s = jnp.where(valid, s + bias, -jnp.inf)
    m = jnp.max(s, axis=-1, keepdims=True)
    p = jnp.exp(s - m)
    den = jnp.sum(p, axis=-1, keepdims=True)
    o = jnp.einsum('brhnqk,brhnkc->brhnqc', p, vv.astype(jnp.float32)) / den
    lse = (m + jnp.log(den))[..., 0]
    o = o.transpose(0, 3, 4, 1, 2, 5).reshape(B, Lp, dilation, H, Dh)[:, :L]
    lse = lse.transpose(0, 3, 4, 1, 2).reshape(B, Lp, dilation, H)[:, :L]
    return o.reshape(B, S, H, Dh), lse.reshape(B, S, H)


def retention_chunkwise(q, k, v):
    B, S, H, Dk = q.shape
    Dv = v.shape[-1]
    C = RET_CHUNK
    nc = S // C
    log_g = jnp.log1p(-jnp.exp2(-5.0 - jnp.arange(H, dtype=jnp.float32)))
    pos = jnp.arange(C, dtype=jnp.float32)
    diff = pos[:, None] - pos[None, :]
    decay_in = jnp.where(diff >= 0, jnp.exp(log_g[:, None, None] * jnp.maximum(diff, 0.0)), 0.0)
    xi = jnp.exp(log_g[:, None] * (pos + 1.0))[..., None]
    zeta = jnp.exp(log_g[:, None] * (C - 1.0 - pos))[..., None]
    g_chunk = jnp.exp(log_g * C)[:, None, None]

    def chunks(t):
        return t.astype(jnp.float32).reshape(B, nc, C, H, t.shape[-1]).transpose(1, 0, 3, 2, 4)

    qc, kc, vc = chunks(q), chunks(k) * (Dk ** -0.5), chunks(v)

    def step(state, inp):
        qi, ki, vi = inp
        att = jnp.einsum('bhqd,bhkd->bhqk', qi, ki) * decay_in
        inner = jnp.einsum('bhqk,bhkv->bhqv', att, vi)
        cross = jnp.einsum('bhqd,bhdv->bhqv', qi, state) * xi
        state = g_chunk * state + jnp.einsum('bhkd,bhkv->bhdv', ki * zeta, vi)
        return state, inner + cross

    state0 = jnp.zeros((B, H, Dk, Dv), jnp.float32)
    _, y = lax.scan(step, state0, (qc, kc, vc))
    return y.transpose(1, 0, 3, 2, 4).reshape(B, S, H, Dv)


def hier_moe(h, w_gr, b_gr, w_er, b_er, w_gate, w_up, w_down):
    N = h.shape[0]
    g_prob = jax.nn.softmax((h @ w_gr + b_gr).astype(jnp.float32), axis=-1)
    g_val, g_idx = lax.top_k(g_prob, 1)
    g_onehot = jax.nn.one_hot(g_idx[:, 0], N_EXPERT_GROUPS, dtype=jnp.float32)
    e_logit = (h @ w_er + b_er).astype(jnp.float32).reshape(N, N_EXPERT_GROUPS, EXPERTS_PER_GROUP)
    e_sel = jnp.einsum('nge,ng->ne', e_logit, g_onehot)
    e_val, e_idx = lax.top_k(e_sel, TOP_K_IN_GROUP)
    e_w = jax.nn.softmax(e_val, axis=-1)
    e_gate = jnp.sum(e_w[..., None] * jax.nn.one_hot(e_idx, EXPERTS_PER_GROUP, dtype=jnp.float32), axis=1)
    gate = (g_val[:, 0:1] * g_onehot)[:, :, None] * e_gate[:, None, :]
    wg = w_gate.reshape(N_EXPERT_GROUPS, EXPERTS_PER_GROUP, D_MODEL, EXPERT_FF)
    wu = w_up.reshape(N_EXPERT_GROUPS, EXPERTS_PER_GROUP, D_MODEL, EXPERT_FF)
    wd = w_down.reshape(N_EXPERT_GROUPS, EXPERTS_PER_GROUP, EXPERT_FF, D_MODEL)
    y = jnp.zeros((N, D_MODEL), jnp.float32)
    for grp in range(N_EXPERT_GROUPS):
        a = jnp.einsum('nd,edf->enf', h, wg[grp])
        u = jnp.einsum('nd,edf->enf', h, wu[grp])
        hid = jax.nn.silu(a) * u * gate[:, grp].T[:, :, None]
        y = y + jnp.einsum('enf,efd->nd', hid, wd[grp])
    return y


def setup_inputs(seed: int = 0) -> dict:
    key = jax.random.key(seed)
    ks = jax.random.split(key, 16)
    f32 = jnp.float32
    nrm = lambda k, shape, fan_in: jax.random.normal(k, shape, f32) * (fan_in ** -0.5)
    gain = lambda k, shape: 1.0 + 0.01 * jax.random.normal(k, shape, f32)
    return {
        "x": jax.random.normal(ks[0], (BATCH, SEQ, D_MODEL), f32),
        "g_mix": gain(ks[1], (DEPTH, D_MODEL)),
        "w_in": nrm(ks[2], (DEPTH, D_MODEL, IN_WIDTH), D_MODEL),
        "w_attn_branch": nrm(ks[3], (DEPTH, ATTN_GROUP_WIDTH, D_MODEL), ATTN_GROUP_WIDTH),
        "w_ret_branch": nrm(ks[4], (DEPTH, RET_V_WIDTH, D_MODEL), RET_V_WIDTH),
        "w_out": nrm(ks[5], (DEPTH, D_MODEL, D_MODEL), D_MODEL),
        "g_ffn": gain(ks[6], (DEPTH, D_MODEL)),
        "w_group_router": nrm(ks[7], (DEPTH, D_MODEL, N_EXPERT_GROUPS), D_MODEL),
        "b_group_router": 0.01 * jax.random.normal(ks[8], (DEPTH, N_EXPERT_GROUPS), f32),
        "w_expert_router": nrm(ks[9], (DEPTH, D_MODEL, N_EXPERTS), D_MODEL),
        "b_expert_router": 0.01 * jax.random.normal(ks[10], (DEPTH, N_EXPERTS), f32),
        "w_gate": nrm(ks[11], (DEPTH, N_EXPERTS, D_MODEL, EXPERT_FF), D_MODEL),
        "w_up": nrm(ks[12], (DEPTH, N_EXPERTS, D_MODEL, EXPERT_FF), D_MODEL),
        "w_down": nrm(ks[13], (DEPTH, N_EXPERTS, EXPERT_FF, D_MODEL), EXPERT_FF),
        "g_final": gain(ks[14], (D_MODEL,)),
    }


def reference(x, g_mix, w_in, w_attn_branch, w_ret_branch, w_out, g_ffn,
              w_group_router, b_group_router, w_expert_router, b_expert_router,
              w_gate, w_up, w_down, g_final):
    B, S, D = x.shape
    slopes = alibi_slopes(ATTN_HEADS)
    split_at = np.cumsum(np.array(IN_SPLITS))[:-1].tolist()
    for layer in range(DEPTH):
        h = rms_norm(x, g_mix[layer])
        proj = h @ w_in[layer]
        qa, ka, va, qr, kr, vr, gr_swish, gate_a, gate_r = jnp.split(proj, split_at, axis=-1)
        qa = qa.reshape(B, S, N_ATTN_GROUPS, ATTN_HEADS, ATTN_HEAD_DIM)
        ka = ka.reshape(B, S, N_ATTN_GROUPS, ATTN_HEADS, ATTN_HEAD_DIM)
        va = va.reshape(B, S, N_ATTN_GROUPS, ATTN_HEADS, ATTN_HEAD_DIM)
        outs, lses = [], []
        for gi, (window, dilation) in enumerate(ATTN_GROUPS):
            o, l = dilated_window_attention(qa[:, :, gi], ka[:, :, gi], va[:, :, gi],
                                            slopes, window, dilation)
            outs.append(o)
            lses.append(l)
        mix_w = jax.nn.softmax(jnp.stack(lses, axis=0), axis=0)
        o_attn = jnp.einsum('gbsh,gbshc->bshc', mix_w, jnp.stack(outs, axis=0))
        o_attn = o_attn.reshape(B, S, ATTN_GROUP_WIDTH).astype(x.dtype)

        yr = retention_chunkwise(qr.reshape(B, S, RET_HEADS, RET_KEY_DIM),
                                 kr.reshape(B, S, RET_HEADS, RET_KEY_DIM),
                                 vr.reshape(B, S, RET_HEADS, RET_VALUE_DIM))
        mu = jnp.mean(yr, axis=-1, keepdims=True)
        var = jnp.mean(jnp.square(yr - mu), axis=-1, keepdims=True)
        yr = ((yr - mu) * lax.rsqrt(var + EPS)).reshape(B, S, RET_V_WIDTH)
        o_ret = (jax.nn.silu(gr_swish.astype(jnp.float32)) * yr).astype(x.dtype)

        merged = (jax.nn.sigmoid(gate_a) * (o_attn @ w_attn_branch[layer])
                  + jax.nn.sigmoid(gate_r) * (o_ret @ w_ret_branch[layer]))
        x = x + merged @ w_out[layer]

        h2 = rms_norm(x, g_ffn[layer]).reshape(B * S, D)
        y = hier_moe(h2, w_group_router[layer], b_group_router[layer],
                     w_expert_router[layer], b_expert_router[layer],
                     w_gate[layer], w_up[layer], w_down[layer])
        x = x + y.reshape(B, S, D).astype(x.dtype)
    return rms_norm(x, g_final)
```

```cpp
#include <hip/hip_runtime.h>
#include <stdint.h>

typedef unsigned short bf16_t;
typedef short bf16x8 __attribute__((ext_vector_type(8)));
typedef float f32x4 __attribute__((ext_vector_type(4)));

#define NTOK 16384
#define SEQ 4096
#define DM 1024
#define MiB ((size_t)1 << 20)

__device__ __forceinline__ bf16_t f2bf(float f) { unsigned u = __float_as_uint(f); return (bf16_t)((u + 0x7fffu + ((u >> 16) & 1u)) >> 16); }
__device__ __forceinline__ float bf2f(bf16_t h) { return __uint_as_float(((unsigned)h) << 16); }
__device__ __forceinline__ float wave_sum(float v) {
#pragma unroll
    for (int o = 32; o >= 1; o >>= 1) v += __shfl_xor(v, o);
    return v;
}
__device__ __forceinline__ float block_sum256(float v, float* red) {
    v = wave_sum(v);
    __syncthreads();
    if ((threadIdx.x & 63) == 0) red[threadIdx.x >> 6] = v;
    __syncthreads();
    return red[0] + red[1] + red[2] + red[3];
}

__global__ __launch_bounds__(256) void k_transpose_bf16(const float* __restrict__ in, bf16_t* __restrict__ out, int R, int C) {
    __shared__ float tile[32][33];
    const float* inb = in + (size_t)blockIdx.z * R * C;
    bf16_t* outb = out + (size_t)blockIdx.z * R * C;
    const int c0 = blockIdx.x * 32, r0 = blockIdx.y * 32;
    const int tx = threadIdx.x & 31, ty = threadIdx.x >> 5;
    for (int i = ty; i < 32; i += 8) tile[i][tx] = inb[(size_t)(r0 + i) * C + c0 + tx];
    __syncthreads();
    for (int i = ty; i < 32; i += 8) outb[(size_t)(c0 + i) * R + r0 + tx] = f2bf(tile[tx][i]);
}

__global__ __launch_bounds__(256) void k_rmsnorm_bf16(const float* __restrict__ x, const float* __restrict__ g, bf16_t* __restrict__ out) {
    __shared__ float red[4];
    const int row = blockIdx.x, t = threadIdx.x;
    const float4 v = ((const float4*)(x + (size_t)row * DM))[t];
    float ss = v.x * v.x + v.y * v.y + v.z * v.z + v.w * v.w;
    ss = block_sum256(ss, red);
    const float r = rsqrtf(ss * (1.0f / DM) + 1e-6f);
    const float4 gg = ((const float4*)g)[t];
    ushort4 o;
    o.x = f2bf(v.x * r * gg.x); o.y = f2bf(v.y * r * gg.y); o.z = f2bf(v.z * r * gg.z); o.w = f2bf(v.w * r * gg.w);
    ((ushort4*)(out + (size_t)row * DM))[t] = o;
}

template <class Epi>
__global__ __launch_bounds__(256) void k_gemm(const bf16_t* __restrict__ A, int lda, const bf16_t* __restrict__ Bt, int ldb, int K, Epi E) {
    const int wid = threadIdx.x >> 6, lane = threadIdx.x & 63;
    const int row0 = blockIdx.y * 128 + (wid >> 1) * 64, col0 = blockIdx.x * 128 + (wid & 1) * 64;
    const int fr = lane & 15, fq = lane >> 4;
    f32x4 acc[4][4];
#pragma unroll
    for (int m = 0; m < 4; ++m)
#pragma unroll
        for (int n = 0; n < 4; ++n) acc[m][n] = (f32x4){0.f, 0.f, 0.f, 0.f};
    const bf16_t* ap = A + (size_t)(row0 + fr) * lda + fq * 8;
    const bf16_t* bp = Bt + (size_t)(col0 + fr) * ldb + fq * 8;
    for (int k0 = 0; k0 < K; k0 += 32) {
        bf16x8 a[4], b[4];
#pragma unroll
        for (int m = 0; m < 4; ++m) a[m] = *(const bf16x8*)(ap + (size_t)m * 16 * lda + k0);
#pragma unroll
        for (int n = 0; n < 4; ++n) b[n] = *(const bf16x8*)(bp + (size_t)n * 16 * ldb + k0);
#pragma unroll
        for (int m = 0; m < 4; ++m)
#pragma unroll
            for (int n = 0; n < 4; ++n) acc[m][n] = __builtin_amdgcn_mfma_f32_16x16x32_bf16(a[m], b[n], acc[m][n], 0, 0, 0);
    }
#pragma unroll
    for (int m = 0; m < 4; ++m)
#pragma unroll
        for (int n = 0; n < 4; ++n)
#pragma unroll
            for (int j = 0; j < 4; ++j) E(row0 + m * 16 + fq * 4 + j, col0 + n * 16 + fr, acc[m][n][j]);
}

struct EpiProj1 {
    bf16_t *qa, *ka, *va, *qr, *kr, *vr, *gsw;
    __device__ __forceinline__ void operator()(int r, int c, float v) const {
        bf16_t* p; int w, lc;
        if (c < 1536) { p = qa; w = 1536; lc = c; }
        else if (c < 3072) { p = ka; w = 1536; lc = c - 1536; }
        else if (c < 4608) { p = va; w = 1536; lc = c - 3072; }
        else if (c < 5120) { p = qr; w = 512; lc = c - 4608; }
        else if (c < 5632) { p = kr; w = 512; lc = c - 5120; }
        else if (c < 6656) { p = vr; w = 1024; lc = c - 5632; }
        else { p = gsw; w = 1024; lc = c - 6656; }
        p[(size_t)r * w + lc] = f2bf(v);
    }
};
struct EpiProj2 {
    bf16_t *ga, *gr;
    __device__ __forceinline__ void operator()(int r, int c, float v) const {
        if (c < 1024) ga[(size_t)r * 1024 + c] = f2bf(v); else gr[(size_t)r * 1024 + c - 1024] = f2bf(v);
    }
};
struct EpiGate {
    const bf16_t* gate; bf16_t* merged; int accumulate;
    __device__ __forceinline__ void operator()(int r, int c, float v) const {
        const size_t i = (size_t)r * 1024 + c;
        const float g = bf2f(gate[i]);
        float o = v / (1.0f + __expf(-g));
        if (accumulate) o += bf2f(merged[i]);
        merged[i] = f2bf(o);
    }
};
struct EpiResid {
    const float* x; float* x1;
    __device__ __forceinline__ void operator()(int r, int c, float v) const {
        const size_t i = (size_t)r * 1024 + c;
        x1[i] = x[i] + v;
    }
};

__global__ __launch_bounds__(256) void k_attn_naive(const bf16_t* __restrict__ qa, const bf16_t* __restrict__ ka, const bf16_t* __restrict__ va, bf16_t* __restrict__ oattn) {
    const int idx = blockIdx.x * 256 + threadIdx.x;
    const int h = idx & 7, t = (idx >> 3) & (SEQ - 1), b = idx >> 15;
    const float slope = exp2f(-(float)(h + 1));
    float m = -1e30f, l = 0.f, o[64];
#pragma unroll
    for (int c = 0; c < 64; ++c) o[c] = 0.f;
    for (int g = 0; g < 3; ++g) {
        const int d = (g == 0) ? 1 : (g == 1 ? 4 : 16);
        float q[64];
        const bf16_t* qp = qa + (size_t)(b * SEQ + t) * 1536 + g * 512 + h * 64;
#pragma unroll
        for (int c = 0; c < 64; ++c) q[c] = bf2f(qp[c]) * 0.125f;
        for (int j = 0; j <= 128; ++j) {
            const int p = t - j * d;
            if (p < 0) break;
            const size_t off = (size_t)(b * SEQ + p) * 1536 + g * 512 + h * 64;
            const bf16_t* kp = ka + off; const bf16_t* vp = va + off;
            float s = 0.f;
#pragma unroll
            for (int c = 0; c < 64; ++c) s += q[c] * bf2f(kp[c]);
            s -= slope * (float)(j * d);
            const float mn = fmaxf(m, s);
            const float a = __expf(m - mn), pw = __expf(s - mn);
            l = l * a + pw;
#pragma unroll
            for (int c = 0; c < 64; ++c) o[c] = o[c] * a + pw * bf2f(vp[c]);
            m = mn;
        }
    }
    const float inv = 1.0f / l;
    bf16_t* op = oattn + (size_t)(b * SEQ + t) * 512 + h * 64;
#pragma unroll
    for (int c = 0; c < 64; ++c) op[c] = f2bf(o[c] * inv);
}

__global__ __launch_bounds__(256) void k_ret_naive(const bf16_t* __restrict__ qr, const bf16_t* __restrict__ kr, const bf16_t* __restrict__ vr, float* __restrict__ y) {
    const int bh = blockIdx.x >> 4, sl = blockIdx.x & 15;
    const int b = bh >> 2, h = bh & 3;
    const int wid = threadIdx.x >> 6, lane = threadIdx.x & 63;
    const int kg = lane & 15, dv = sl * 16 + wid * 4 + (lane >> 4);
    const float gamma = 1.0f - exp2f(-5.0f - (float)h);
    const float ksc = 0.08838834764831845f;
    float S[8];
#pragma unroll
    for (int i = 0; i < 8; ++i) S[i] = 0.f;
    for (int t = 0; t < SEQ; ++t) {
        const size_t row = (size_t)b * SEQ + t;
        const bf16x8 qv = *(const bf16x8*)(qr + row * 512 + h * 128 + kg * 8);
        const bf16x8 kv = *(const bf16x8*)(kr + row * 512 + h * 128 + kg * 8);
        const float v = bf2f(vr[row * 1024 + h * 256 + dv]);
        float part = 0.f;
#pragma unroll
        for (int i = 0; i < 8; ++i) {
            S[i] = gamma * S[i] + (bf2f((bf16_t)kv[i]) * ksc) * v;
            part += bf2f((bf16_t)qv[i]) * S[i];
        }
        part += __shfl_xor(part, 1); part += __shfl_xor(part, 2); part += __shfl_xor(part, 4); part += __shfl_xor(part, 8);
        if (kg == 0) y[row * 1024 + h * 256 + dv] = part;
    }
}

__global__ __launch_bounds__(256) void k_groupnorm_swish(const float* __restrict__ y, const bf16_t* __restrict__ gsw, bf16_t* __restrict__ oret) {
    const int row = blockIdx.x, lane = threadIdx.x & 63;
    const size_t base = (size_t)row * 1024 + (threadIdx.x >> 6) * 256 + lane * 4;
    const float4 v = *(const float4*)(y + base);
    const float mu = wave_sum(v.x + v.y + v.z + v.w) * (1.0f / 256.0f);
    const float dx = v.x - mu, dy = v.y - mu, dz = v.z - mu, dw = v.w - mu;
    const float var = wave_sum(dx * dx + dy * dy + dz * dz + dw * dw) * (1.0f / 256.0f);
    const float r = rsqrtf(var + 1e-6f);
    const ushort4 gs = *(const ushort4*)(gsw + base);
    const float g0 = bf2f(gs.x), g1 = bf2f(gs.y), g2 = bf2f(gs.z), g3 = bf2f(gs.w);
    ushort4 o;
    o.x = f2bf(g0 / (1.0f + __expf(-g0)) * dx * r);
    o.y = f2bf(g1 / (1.0f + __expf(-g1)) * dy * r);
    o.z = f2bf(g2 / (1.0f + __expf(-g2)) * dz * r);
    o.w = f2bf(g3 / (1.0f + __expf(-g3)) * dw * r);
    *(ushort4*)(oret + base) = o;
}

__global__ __launch_bounds__(256) void k_moe_naive(const float* __restrict__ x1, const float* __restrict__ g_ffn,
                                                   const float* __restrict__ w_gr, const float* __restrict__ b_gr,
                                                   const float* __restrict__ w_er, const float* __restrict__ b_er,
                                                   const float* __restrict__ wg, const float* __restrict__ wu, const float* __restrict__ wd,
                                                   const float* __restrict__ g_final, float* __restrict__ out) {
    __shared__ float h2[1024];
    __shared__ float hid[512];
    __shared__ float red[4];
    __shared__ float logits[36];
    __shared__ int sel_e[2];
    __shared__ float sel_w[2];
    const int row = blockIdx.x, t = threadIdx.x, wid = t >> 6, lane = t & 63;
    const float4 xv = ((const float4*)(x1 + (size_t)row * DM))[t];
    float ss = xv.x * xv.x + xv.y * xv.y + xv.z * xv.z + xv.w * xv.w;
    ss = block_sum256(ss, red);
    const float r = rsqrtf(ss * (1.0f / DM) + 1e-6f);
    const float4 gg = ((const float4*)g_ffn)[t];
    h2[4 * t + 0] = xv.x * r * gg.x; h2[4 * t + 1] = xv.y * r * gg.y; h2[4 * t + 2] = xv.z * r * gg.z; h2[4 * t + 3] = xv.w * r * gg.w;
    __syncthreads();
    for (int j = wid; j < 36; j += 4) {
        float s = 0.f;
        for (int k = lane; k < 1024; k += 64) s += h2[k] * (j < 4 ? w_gr[k * 4 + j] : w_er[k * 32 + (j - 4)]);
        s = wave_sum(s);
        if (lane == 0) logits[j] = s + (j < 4 ? b_gr[j] : b_er[j - 4]);
    }
    __syncthreads();
    if (t == 0) {
        int gi = 0; float mx = logits[0];
        for (int j = 1; j < 4; ++j) if (logits[j] > mx) { mx = logits[j]; gi = j; }
        float sum = 0.f;
        for (int j = 0; j < 4; ++j) sum += __expf(logits[j] - mx);
        const float gval = 1.0f / sum;
        const float* el = logits + 4 + gi * 8;
        int i1 = 0; float v1 = el[0];
        for (int j = 1; j < 8; ++j) if (el[j] > v1) { v1 = el[j]; i1 = j; }
        int i2 = -1; float v2 = -1e30f;
        for (int j = 0; j < 8; ++j) if (j != i1 && el[j] > v2) { v2 = el[j]; i2 = j; }
        const float e2 = __expf(v2 - v1);
        sel_e[0] = gi * 8 + i1; sel_e[1] = gi * 8 + i2;
        sel_w[0] = gval / (1.0f + e2); sel_w[1] = gval * e2 / (1.0f + e2);
    }
    __syncthreads();
    float yacc[4] = {0.f, 0.f, 0.f, 0.f};
    for (int s = 0; s < 2; ++s) {
        const int e = sel_e[s]; const float w = sel_w[s];
        const float* wge = wg + (size_t)e * 1024 * 512;
        const float* wue = wu + (size_t)e * 1024 * 512;
        const float* wde = wd + (size_t)e * 512 * 1024;
        for (int f = t; f < 512; f += 256) {
            float a = 0.f, u = 0.f;
            for (int k = 0; k < 1024; ++k) { const float hv = h2[k]; a += hv * wge[(size_t)k * 512 + f]; u += hv * wue[(size_t)k * 512 + f]; }
            hid[f] = a / (1.0f + __expf(-a)) * u * w;
        }
        __syncthreads();
#pragma unroll
        for (int i = 0; i < 4; ++i) {
            const int d = t + 256 * i;
            float acc = 0.f;
            for (int f = 0; f < 512; ++f) acc += hid[f] * wde[(size_t)f * 1024 + d];
            yacc[i] += acc;
        }
        __syncthreads();
    }
    float xo[4]; float s2 = 0.f;
#pragma unroll
    for (int i = 0; i < 4; ++i) { xo[i] = x1[(size_t)row * DM + t + 256 * i] + yacc[i]; s2 += xo[i] * xo[i]; }
    s2 = block_sum256(s2, red);
    const float r2 = rsqrtf(s2 * (1.0f / DM) + 1e-6f);
#pragma unroll
    for (int i = 0; i < 4; ++i) out[(size_t)row * DM + t + 256 * i] = xo[i] * r2 * g_final[t + 256 * i];
}

extern "C" void kernel_launch(void* const* d_in, const int* in_sizes, int n_in, void* d_out, int out_size, void* d_ws, size_t ws_size, hipStream_t stream) {
    const float* x = (const float*)d_in[0];
    const float* g_mix = (const float*)d_in[1];
    const float* w_in = (const float*)d_in[2];
    const float* w_ab = (const float*)d_in[3];
    const float* w_rb = (const float*)d_in[4];
    const float* w_out = (const float*)d_in[5];
    const float* g_ffn = (const float*)d_in[6];
    const float* w_gr = (const float*)d_in[7];
    const float* b_gr = (const float*)d_in[8];
    const float* w_er = (const float*)d_in[9];
    const float* b_er = (const float*)d_in[10];
    const float* w_gate = (const float*)d_in[11];
    const float* w_up = (const float*)d_in[12];
    const float* w_down = (const float*)d_in[13];
    const float* g_final = (const float*)d_in[14];
    float* out = (float*)d_out;
    char* ws = (char*)d_ws;
    char* ob = (char*)d_out;

    bf16_t* qa = (bf16_t*)(ws + 0 * MiB);
    bf16_t* ka = (bf16_t*)(ws + 48 * MiB);
    bf16_t* va = (bf16_t*)(ws + 96 * MiB);
    bf16_t* qr = (bf16_t*)(ws + 144 * MiB);
    bf16_t* kr = (bf16_t*)(ws + 160 * MiB);
    bf16_t* vr = (bf16_t*)(ws + 176 * MiB);
    bf16_t* WinT = (bf16_t*)(ws + 208 * MiB);
    bf16_t* PAt = (bf16_t*)(ws + 227 * MiB);
    bf16_t* PRt = (bf16_t*)(ws + 228 * MiB);
    bf16_t* WoT = (bf16_t*)(ws + 230 * MiB);
    bf16_t* oattn = (bf16_t*)(ws + 232 * MiB);
    bf16_t* hb = (bf16_t*)(ob + 0 * MiB);
    bf16_t* gsw = (bf16_t*)(ob + 32 * MiB);
    bf16_t* ga = (bf16_t*)(ws + 0 * MiB);
    bf16_t* gr = (bf16_t*)(ws + 32 * MiB);
    float* y = (float*)(ws + 64 * MiB);
    bf16_t* oret = (bf16_t*)(ws + 128 * MiB);
    bf16_t* merged = (bf16_t*)(ws + 160 * MiB);
    float* x1 = (float*)(ws + 64 * MiB);

    k_transpose_bf16<<<dim3(9728 / 32, 1024 / 32, 1), 256, 0, stream>>>(w_in, WinT, 1024, 9728);
    k_transpose_bf16<<<dim3(1024 / 32, 512 / 32, 1), 256, 0, stream>>>(w_ab, PAt, 512, 1024);
    k_transpose_bf16<<<dim3(1024 / 32, 1024 / 32, 1), 256, 0, stream>>>(w_rb, PRt, 1024, 1024);
    k_transpose_bf16<<<dim3(1024 / 32, 1024 / 32, 1), 256, 0, stream>>>(w_out, WoT, 1024, 1024);
    k_rmsnorm_bf16<<<NTOK, 256, 0, stream>>>(x, g_mix, hb);
    {
        EpiProj1 e{qa, ka, va, qr, kr, vr, gsw};
        k_gemm<EpiProj1><<<dim3(7680 / 128, NTOK / 128), 256, 0, stream>>>(hb, 1024, WinT, 1024, 1024, e);
    }
    k_attn_naive<<<NTOK * 8 / 256, 256, 0, stream>>>(qa, ka, va, oattn);
    {
        EpiProj2 e{ga, gr};
        k_gemm<EpiProj2><<<dim3(2048 / 128, NTOK / 128), 256, 0, stream>>>(hb, 1024, WinT + (size_t)7680 * 1024, 1024, 1024, e);
    }
    k_ret_naive<<<256, 256, 0, stream>>>(qr, kr, vr, y);
    k_groupnorm_swish<<<NTOK, 256, 0, stream>>>(y, gsw, oret);
    {
        EpiGate e{ga, merged, 0};
        k_gemm<EpiGate><<<dim3(1024 / 128, NTOK / 128), 256, 0, stream>>>(oattn, 512, PAt, 512, 512, e);
    }
    {
        EpiGate e{gr, merged, 1};
        k_gemm<EpiGate><<<dim3(1024 / 128, NTOK / 128), 256, 0, stream>>>(oret, 1024, PRt, 1024, 1024, e);
    }
    {
        EpiResid e{x, x1};
        k_gemm<EpiResid><<<dim3(1024 / 128, NTOK / 128), 256, 0, stream>>>(merged, 1024, WoT, 1024, 1024, e);
    }
    k_moe_naive<<<NTOK, 256, 0, stream>>>(x1, g_ffn, w_gr, b_gr, w_er, b_er, w_gate, w_up, w_down, g_final, out);
}
```

```cpp
#include <hip/hip_runtime.h>
#include <hip/hip_cooperative_groups.h>
#include <stdint.h>
#include <cstdio>
namespace cg = cooperative_groups;

typedef unsigned short bf16_t;
typedef short bf16x8 __attribute__((ext_vector_type(8)));
typedef float f32x4 __attribute__((ext_vector_type(4)));

#define NTOK 16384
#define SEQ 4096
#define DM 1024
#define MiB ((size_t)1 << 20)

__device__ __forceinline__ bf16_t f2bf(float f) { unsigned u = __float_as_uint(f); return (bf16_t)((u + 0x7fffu + ((u >> 16) & 1u)) >> 16); }
__device__ __forceinline__ float bf2f(bf16_t h) { return __uint_as_float(((unsigned)h) << 16); }
__device__ __forceinline__ float wave_sum(float v) {
#pragma unroll
    for (int o = 32; o >= 1; o >>= 1) v += __shfl_xor(v, o);
    return v;
}
__device__ __forceinline__ float block_sum256(float v, float* red) {
    v = wave_sum(v);
    __syncthreads();
    if ((threadIdx.x & 63) == 0) red[threadIdx.x >> 6] = v;
    __syncthreads();
    return red[0] + red[1] + red[2] + red[3];
}


#define NTHR 512
#define LDS_BYTES 147456

struct Params {
    const float *x, *g_mix, *w_in, *w_ab, *w_rb, *w_out, *g_ffn, *w_gr, *b_gr, *w_er, *b_er, *w_gate, *w_up, *w_down, *g_final;
    float* out; char* ws; char* ob;
};

__device__ __forceinline__ float block_sum512(float v, float* red) {
    v = wave_sum(v);
    __syncthreads();
    if ((threadIdx.x & 63) == 0) red[threadIdx.x >> 6] = v;
    __syncthreads();
    float s = 0.f;
#pragma unroll
    for (int i = 0; i < 8; ++i) s += red[i];
    return s;
}

__device__ __forceinline__ void ph_transpose(const float* __restrict__ in, bf16_t* __restrict__ out, int R, int C, int nbatch, float* lds) {
    const int half = threadIdx.x >> 8, t = threadIdx.x & 255, tx = t & 31, ty = t >> 5;
    float* tile = lds + half * (32 * 33);
    const int tc = C / 32, tr = R / 32, per = tc * tr, total = per * nbatch;
    for (int it = blockIdx.x * 2; it < total; it += gridDim.x * 2) {
        const int id = it + half;
        __syncthreads();
        if (id < total) {
            const int bz = id / per, rem = id % per, c0 = (rem % tc) * 32, r0 = (rem / tc) * 32;
            const float* inb = in + (size_t)bz * R * C;
            for (int i = ty; i < 32; i += 8) tile[i * 33 + tx] = inb[(size_t)(r0 + i) * C + c0 + tx];
        }
        __syncthreads();
        if (id < total) {
            const int bz = id / per, rem = id % per, c0 = (rem % tc) * 32, r0 = (rem / tc) * 32;
            bf16_t* outb = out + (size_t)bz * R * C;
            for (int i = ty; i < 32; i += 8) outb[(size_t)(c0 + i) * R + r0 + tx] = f2bf(tile[tx * 33 + i]);
        }
    }
}

__device__ __forceinline__ void ph_rmsnorm_bf16(const float* __restrict__ x, const float* __restrict__ g, bf16_t* __restrict__ out) {
    const int lane = threadIdx.x & 63, gw = blockIdx.x * 8 + (threadIdx.x >> 6), ngw = gridDim.x * 8;
    for (int row = gw; row < NTOK; row += ngw) {
        float4 v[4]; float ss = 0.f;
#pragma unroll
        for (int j = 0; j < 4; ++j) { v[j] = ((const float4*)(x + (size_t)row * DM))[lane + 64 * j]; ss += v[j].x * v[j].x + v[j].y * v[j].y + v[j].z * v[j].z + v[j].w * v[j].w; }
        ss = wave_sum(ss);
        const float r = rsqrtf(ss * (1.0f / DM) + 1e-6f);
#pragma unroll
        for (int j = 0; j < 4; ++j) {
            const float4 gg = ((const float4*)g)[lane + 64 * j];
            ushort4 o; o.x = f2bf(v[j].x * r * gg.x); o.y = f2bf(v[j].y * r * gg.y); o.z = f2bf(v[j].z * r * gg.z); o.w = f2bf(v[j].w * r * gg.w);
            ((ushort4*)(out + (size_t)row * DM))[lane + 64 * j] = o;
        }
    }
}

template <class Epi>
__device__ __forceinline__ void ph_gemm(const bf16_t* __restrict__ A, int lda, const bf16_t* __restrict__ Bt, int ldb, int M, int N, int K, const Epi& E) {
    const int wid = threadIdx.x >> 6, lane = threadIdx.x & 63, fr = lane & 15, fq = lane >> 4;
    const int tn = N / 256, total = (M / 128) * tn;
    for (int tl = blockIdx.x; tl < total; tl += gridDim.x) {
        const int row0 = (tl / tn) * 128 + (wid >> 2) * 64, col0 = (tl % tn) * 256 + (wid & 3) * 64;
        f32x4 acc[4][4];
#pragma unroll
        for (int m = 0; m < 4; ++m)
#pragma unroll
            for (int n = 0; n < 4; ++n) acc[m][n] = (f32x4){0.f, 0.f, 0.f, 0.f};
        const bf16_t* ap = A + (size_t)(row0 + fr) * lda + fq * 8;
        const bf16_t* bp = Bt + (size_t)(col0 + fr) * ldb + fq * 8;
        for (int k0 = 0; k0 < K; k0 += 32) {
            bf16x8 a[4], b[4];
#pragma unroll
            for (int m = 0; m < 4; ++m) a[m] = *(const bf16x8*)(ap + (size_t)m * 16 * lda + k0);
#pragma unroll
            for (int n = 0; n < 4; ++n) b[n] = *(const bf16x8*)(bp + (size_t)n * 16 * ldb + k0);
#pragma unroll
            for (int m = 0; m < 4; ++m)
#pragma unroll
                for (int n = 0; n < 4; ++n) acc[m][n] = __builtin_amdgcn_mfma_f32_16x16x32_bf16(a[m], b[n], acc[m][n], 0, 0, 0);
        }
#pragma unroll
        for (int m = 0; m < 4; ++m)
#pragma unroll
            for (int n = 0; n < 4; ++n)
#pragma unroll
                for (int j = 0; j < 4; ++j) E(row0 + m * 16 + fq * 4 + j, col0 + n * 16 + fr, acc[m][n][j]);
    }
}
struct EpiProj1 {
    bf16_t *qa, *ka, *va, *qr, *kr, *vr, *gsw;
    __device__ __forceinline__ void operator()(int r, int c, float v) const {
        const bf16_t o = f2bf(v);
        if (c < 1536) qa[(size_t)r * 1536 + c] = o;
        else if (c < 3072) ka[(size_t)r * 1536 + c - 1536] = o;
        else if (c < 4608) va[(size_t)r * 1536 + c - 3072] = o;
        else if (c < 5120) qr[(size_t)r * 512 + c - 4608] = o;
        else if (c < 5632) kr[(size_t)r * 512 + c - 5120] = o;
        else if (c < 6656) vr[(size_t)r * 1024 + c - 5632] = o;
        else gsw[(size_t)r * 1024 + c - 6656] = o;
    }
};
struct EpiProj2 {
    bf16_t *ga, *gr;
    __device__ __forceinline__ void operator()(int r, int c, float v) const {
        if (c < 1024) ga[(size_t)r * 1024 + c] = f2bf(v); else gr[(size_t)r * 1024 + c - 1024] = f2bf(v);
    }
};
struct EpiGate {
    const bf16_t* gate; bf16_t* merged; int accumulate;
    __device__ __forceinline__ void operator()(int r, int c, float v) const {
        const size_t i = (size_t)r * 1024 + c;
        const float g = bf2f(gate[i]);
        float o = v / (1.0f + __expf(-g));
        if (accumulate) o += bf2f(merged[i]);
        merged[i] = f2bf(o);
    }
};
struct EpiResid {
    const float* x; float* x1;
    __device__ __forceinline__ void operator()(int r, int c, float v) const {
        const size_t i = (size_t)r * 1024 + c;
        x1[i] = x[i] + v;
    }
};

__device__ __forceinline__ void ph_attn_naive(const bf16_t* __restrict__ qa, const bf16_t* __restrict__ ka, const bf16_t* __restrict__ va, bf16_t* __restrict__ oattn) {
  for (int idx = blockIdx.x * NTHR + threadIdx.x; idx < NTOK * 8; idx += gridDim.x * NTHR) {
    const int h = idx & 7, t = (idx >> 3) & (SEQ - 1), b = idx >> 15;
    const float slope = exp2f(-(float)(h + 1));
    float m = -1e30f, l = 0.f, o[64];
#pragma unroll
    for (int c = 0; c < 64; ++c) o[c] = 0.f;
    for (int g = 0; g < 3; ++g) {
        const int d = (g == 0) ? 1 : (g == 1 ? 4 : 16);
        float q[64];
        const bf16_t* qp = qa + (size_t)(b * SEQ + t) * 1536 + g * 512 + h * 64;
#pragma unroll
        for (int c = 0; c < 64; ++c) q[c] = bf2f(qp[c]) * 0.125f;
        for (int j = 0; j <= 128; ++j) {
            const int p = t - j * d;
            if (p < 0) break;
            const size_t off = (size_t)(b * SEQ + p) * 1536 + g * 512 + h * 64;
            const bf16_t* kp = ka + off; const bf16_t* vp = va + off;
            float s = 0.f;
#pragma unroll
            for (int c = 0; c < 64; ++c) s += q[c] * bf2f(kp[c]);
            s -= slope * (float)(j * d);
            const float mn = fmaxf(m, s);
            const float a = __expf(m - mn), pw = __expf(s - mn);
            l = l * a + pw;
#pragma unroll
            for (int c = 0; c < 64; ++c) o[c] = o[c] * a + pw * bf2f(vp[c]);
            m = mn;
        }
    }
    const float inv = 1.0f / l;
    bf16_t* op = oattn + (size_t)(b * SEQ + t) * 512 + h * 64;
#pragma unroll
    for (int c = 0; c < 64; ++c) op[c] = f2bf(o[c] * inv);
  }
}


__device__ __forceinline__ void ph_ret_naive(const bf16_t* __restrict__ qr, const bf16_t* __restrict__ kr, const bf16_t* __restrict__ vr, float* __restrict__ y) {
    for (int unit = blockIdx.x; unit < 128; unit += gridDim.x) {
        const int bh = unit >> 3, sl = unit & 7;
        const int b = bh >> 2, h = bh & 3;
        const int wid = threadIdx.x >> 6, lane = threadIdx.x & 63;
        const int kg = lane & 15, dv = sl * 32 + wid * 4 + (lane >> 4);
        const float gamma = 1.0f - exp2f(-5.0f - (float)h);
        const float ksc = 0.08838834764831845f;
        float S[8];
#pragma unroll
        for (int i = 0; i < 8; ++i) S[i] = 0.f;
        for (int t = 0; t < SEQ; ++t) {
            const size_t row = (size_t)b * SEQ + t;
            const bf16x8 qv = *(const bf16x8*)(qr + row * 512 + h * 128 + kg * 8);
            const bf16x8 kv = *(const bf16x8*)(kr + row * 512 + h * 128 + kg * 8);
            const float v = bf2f(vr[row * 1024 + h * 256 + dv]);
            float part = 0.f;
#pragma unroll
            for (int i = 0; i < 8; ++i) {
                S[i] = gamma * S[i] + (bf2f((bf16_t)kv[i]) * ksc) * v;
                part += bf2f((bf16_t)qv[i]) * S[i];
            }
            part += __shfl_xor(part, 1); part += __shfl_xor(part, 2); part += __shfl_xor(part, 4); part += __shfl_xor(part, 8);
            if (kg == 0) y[row * 1024 + h * 256 + dv] = part;
        }
    }
}

__device__ __forceinline__ void ph_groupnorm_swish(const float* __restrict__ y, const bf16_t* __restrict__ gsw, bf16_t* __restrict__ oret) {
    const int lane = threadIdx.x & 63, gw = blockIdx.x * 8 + (threadIdx.x >> 6), ngw = gridDim.x * 8;
    for (int it = gw; it < NTOK * 4; it += ngw) {
        const size_t base = (size_t)it * 256 + lane * 4;
        const float4 v = *(const float4*)(y + base);
        const float mu = wave_sum(v.x + v.y + v.z + v.w) * (1.0f / 256.0f);
        const float dx = v.x - mu, dy = v.y - mu, dz = v.z - mu, dw = v.w - mu;
        const float var = wave_sum(dx * dx + dy * dy + dz * dz + dw * dw) * (1.0f / 256.0f);
        const float r = rsqrtf(var + 1e-6f);
        const ushort4 gs = *(const ushort4*)(gsw + base);
        const float g0 = bf2f(gs.x), g1 = bf2f(gs.y), g2 = bf2f(gs.z), g3 = bf2f(gs.w);
        ushort4 o;
        o.x = f2bf(g0 / (1.0f + __expf(-g0)) * dx * r);
        o.y = f2bf(g1 / (1.0f + __expf(-g1)) * dy * r);
        o.z = f2bf(g2 / (1.0f + __expf(-g2)) * dz * r);
        o.w = f2bf(g3 / (1.0f + __expf(-g3)) * dw * r);
        *(ushort4*)(oret + base) = o;
    }
}

__device__ __forceinline__ void ph_moe_naive(const Params& p, const float* __restrict__ x1, float* lds) {
    float* h2 = lds;
    float* hid = lds + 1024;
    float* red = lds + 1536;
    float* logits = lds + 1544;
    int* sel_e = (int*)(lds + 1584);
    float* sel_w = lds + 1588;
    const int t = threadIdx.x, wid = t >> 6, lane = t & 63;
    for (int row = blockIdx.x; row < NTOK; row += gridDim.x) {
        __syncthreads();
        const float2 xv = ((const float2*)(x1 + (size_t)row * DM))[t];
        float ss = xv.x * xv.x + xv.y * xv.y;
        ss = block_sum512(ss, red);
        const float r = rsqrtf(ss * (1.0f / DM) + 1e-6f);
        const float2 gg = ((const float2*)p.g_ffn)[t];
        h2[2 * t + 0] = xv.x * r * gg.x; h2[2 * t + 1] = xv.y * r * gg.y;
        __syncthreads();
        for (int j = wid; j < 36; j += 8) {
            float s = 0.f;
            for (int k = lane; k < 1024; k += 64) s += h2[k] * (j < 4 ? p.w_gr[k * 4 + j] : p.w_er[k * 32 + (j - 4)]);
            s = wave_sum(s);
            if (lane == 0) logits[j] = s + (j < 4 ? p.b_gr[j] : p.b_er[j - 4]);
        }
        __syncthreads();
        if (t == 0) {
            int gi = 0; float mx = logits[0];
            for (int j = 1; j < 4; ++j) if (logits[j] > mx) { mx = logits[j]; gi = j; }
            float sum = 0.f;
            for (int j = 0; j < 4; ++j) sum += __expf(logits[j] - mx);
            const float gval = 1.0f / sum;
            const float* el = logits + 4 + gi * 8;
            int i1 = 0; float v1 = el[0];
            for (int j = 1; j < 8; ++j) if (el[j] > v1) { v1 = el[j]; i1 = j; }
            int i2 = -1; float v2 = -1e30f;
            for (int j = 0; j < 8; ++j) if (j != i1 && el[j] > v2) { v2 = el[j]; i2 = j; }
            const float e2 = __expf(v2 - v1);
            sel_e[0] = gi * 8 + i1; sel_e[1] = gi * 8 + i2;
            sel_w[0] = gval / (1.0f + e2); sel_w[1] = gval * e2 / (1.0f + e2);
        }
        __syncthreads();
        float yacc[2] = {0.f, 0.f};
        for (int s = 0; s < 2; ++s) {
            const int e = sel_e[s]; const float w = sel_w[s];
            const float* wge = p.w_gate + (size_t)e * 1024 * 512;
            const float* wue = p.w_up + (size_t)e * 1024 * 512;
            const float* wde = p.w_down + (size_t)e * 512 * 1024;
            {
                const int f = t;
                float a = 0.f, u = 0.f;
                for (int k = 0; k < 1024; ++k) { const float hv = h2[k]; a += hv * wge[(size_t)k * 512 + f]; u += hv * wue[(size_t)k * 512 + f]; }
                hid[f] = a / (1.0f + __expf(-a)) * u * w;
            }
            __syncthreads();
#pragma unroll
            for (int i = 0; i < 2; ++i) {
                const int d = t + 512 * i;
                float acc = 0.f;
                for (int f = 0; f < 512; ++f) acc += hid[f] * wde[(size_t)f * 1024 + d];
                yacc[i] += acc;
            }
            __syncthreads();
        }
        float xo[2]; float s2 = 0.f;
#pragma unroll
        for (int i = 0; i < 2; ++i) { xo[i] = x1[(size_t)row * DM + t + 512 * i] + yacc[i]; s2 += xo[i] * xo[i]; }
        s2 = block_sum512(s2, red);
        const float r2 = rsqrtf(s2 * (1.0f / DM) + 1e-6f);
#pragma unroll
        for (int i = 0; i < 2; ++i) p.out[(size_t)row * DM + t + 512 * i] = xo[i] * r2 * p.g_final[t + 512 * i];
    }
}

__global__ void __launch_bounds__(NTHR, 2) fwd_megakernel(Params p) {
    extern __shared__ __attribute__((aligned(16))) unsigned char lds_raw[];
    float* lds = (float*)lds_raw;
    cg::grid_group grid = cg::this_grid();
    char* ws = p.ws; char* ob = p.ob;
    bf16_t* qa = (bf16_t*)(ws + 0 * MiB);
    bf16_t* ka = (bf16_t*)(ws + 48 * MiB);
    bf16_t* va = (bf16_t*)(ws + 96 * MiB);
    bf16_t* qr = (bf16_t*)(ws + 144 * MiB);
    bf16_t* kr = (bf16_t*)(ws + 160 * MiB);
    bf16_t* vr = (bf16_t*)(ws + 176 * MiB);
    bf16_t* WinT = (bf16_t*)(ws + 208 * MiB);
    bf16_t* PAt = (bf16_t*)(ws + 227 * MiB);
    bf16_t* PRt = (bf16_t*)(ws + 228 * MiB);
    bf16_t* WoT = (bf16_t*)(ws + 230 * MiB);
    bf16_t* oattn = (bf16_t*)(ws + 232 * MiB);
    bf16_t* hb = (bf16_t*)(ob + 0 * MiB);
    bf16_t* gsw = (bf16_t*)(ob + 32 * MiB);
    bf16_t* ga = (bf16_t*)(ws + 0 * MiB);
    bf16_t* gr = (bf16_t*)(ws + 32 * MiB);
    float* y = (float*)(ws + 64 * MiB);
    bf16_t* oret = (bf16_t*)(ws + 128 * MiB);
    bf16_t* merged = (bf16_t*)(ws + 160 * MiB);
    float* x1 = (float*)(ws + 64 * MiB);

    ph_transpose(p.w_in, WinT, 1024, 9728, 1, lds);
    ph_transpose(p.w_ab, PAt, 512, 1024, 1, lds);
    ph_transpose(p.w_rb, PRt, 1024, 1024, 1, lds);
    ph_transpose(p.w_out, WoT, 1024, 1024, 1, lds);
    ph_rmsnorm_bf16(p.x, p.g_mix, hb);
    grid.sync();
    { EpiProj1 e{qa, ka, va, qr, kr, vr, gsw}; ph_gemm(hb, 1024, WinT, 1024, NTOK, 7680, 1024, e); }
    grid.sync();
    ph_attn_naive(qa, ka, va, oattn);
    grid.sync();
    { EpiProj2 e{ga, gr}; ph_gemm(hb, 1024, WinT + (size_t)7680 * 1024, 1024, NTOK, 2048, 1024, e); }
    grid.sync();
    ph_ret_naive(qr, kr, vr, y);
    grid.sync();
    ph_groupnorm_swish(y, gsw, oret);
    grid.sync();
    { EpiGate e{ga, merged, 0}; ph_gemm(oattn, 512, PAt, 512, NTOK, 1024, 512, e); }
    { EpiGate e{gr, merged, 1}; ph_gemm(oret, 1024, PRt, 1024, NTOK, 1024, 1024, e); }
    grid.sync();
    { EpiResid e{p.x, x1}; ph_gemm(merged, 1024, WoT, 1024, NTOK, 1024, 1024, e); }
    grid.sync();
    ph_moe_naive(p, x1, lds);
}

extern "C" void kernel_launch(void* const* d_in, const int* in_sizes, int n_in, void* d_out, int out_size, void* d_ws, size_t ws_size, hipStream_t stream) {
    static int grid_blocks = 0;
    if (!grid_blocks) {
        int dev = 0, cus = 0, per_cu = 0;
        hipGetDevice(&dev);
        hipDeviceGetAttribute(&cus, hipDeviceAttributeMultiprocessorCount, dev);
        hipFuncSetAttribute((const void*)fwd_megakernel, hipFuncAttributeMaxDynamicSharedMemorySize, LDS_BYTES);
        hipOccupancyMaxActiveBlocksPerMultiprocessor(&per_cu, (const void*)fwd_megakernel, NTHR, LDS_BYTES);
        if (per_cu > 1) per_cu = 1;
        grid_blocks = cus * per_cu;
        if (grid_blocks <= 0 || ws_size < 300 * MiB) { fprintf(stderr, "kernel_launch: cannot launch (grid %d, ws %zu)\n", grid_blocks, ws_size); grid_blocks = -1; }
    }
    if (grid_blocks < 0) return;
    Params p{};
    p.x = (const float*)d_in[0]; p.g_mix = (const float*)d_in[1]; p.w_in = (const float*)d_in[2]; p.w_ab = (const float*)d_in[3];
    p.w_rb = (const float*)d_in[4]; p.w_out = (const float*)d_in[5]; p.g_ffn = (const float*)d_in[6]; p.w_gr = (const float*)d_in[7];
    p.b_gr = (const float*)d_in[8]; p.w_er = (const float*)d_in[9]; p.b_er = (const float*)d_in[10]; p.w_gate = (const float*)d_in[11];
    p.w_up = (const float*)d_in[12]; p.w_down = (const float*)d_in[13]; p.g_final = (const float*)d_in[14];
    p.out = (float*)d_out; p.ws = (char*)d_ws; p.ob = (char*)d_out;
    void* args[] = {&p};
    hipError_t e = hipLaunchCooperativeKernel((const void*)fwd_megakernel, dim3(grid_blocks), dim3(NTHR), args, LDS_BYTES, stream);
    if (e != hipSuccess) fprintf(stderr, "cooperative launch failed: %s (grid %d)\n", hipGetErrorString(e), grid_blocks);
}
```

```cpp
#include <hip/hip_runtime.h>
#include <hip/hip_cooperative_groups.h>
#include <stdint.h>
#include <cstdio>
namespace cg = cooperative_groups;

namespace pg8 {
#define PG8_LAS __attribute__((address_space(3)))
typedef unsigned short bf16_t;
typedef short bf16x8 __attribute__((ext_vector_type(8)));
typedef float f32x4 __attribute__((ext_vector_type(4)));
typedef unsigned u32x4 __attribute__((ext_vector_type(4)));
constexpr int BM = 256, BK = 64, HALF = 128, HTB = HALF * BK * 2  , STAGE_BYTES = 8 * HTB, NXCD = 8, WGM = 8;

__host__ __device__ __forceinline__ int lds_byte(int r, int c) { const int st = (r >> 4) * 2 + (c >> 5), rr = r & 15, cc = c & 31, ob = rr * 64 + cc * 2; return st * 1024 + (ob ^ (((ob >> 9) & 1) << 5)); }
__host__ __device__ __forceinline__ void stage_rc(int b, int& R, int& C) { const int st = b / 1024, sb = b % 1024, swz = sb ^ (((sb >> 9) & 1) << 5); R = (st >> 1) * 16 + swz / 64; C = (st & 1) * 32 + (swz % 64) / 2; }
__host__ __device__ __forceinline__ int perm32(int rho) { const int n = rho >> 4, i = rho & 15; return 8 * (i >> 2) + 4 * n + (i & 3); }

struct Unit { int pm, pn; };
struct Gemm { const bf16_t* A; const bf16_t* Bt; int M, N, K; };

struct StaticOrder {
    int nM, nN, nwg, G, c;
    __host__ __device__ void init(int M, int N, int G_, int c_) { nM = M / BM; nN = N / BM; nwg = nM * nN; G = G_; c = c_; }
    __host__ __device__ bool next(int i, Unit& u) const {
        const long L = (long)i * G + c; if (L >= nwg) return false;
        int wgid = (int)L; { const int q = nwg / NXCD, r = nwg % NXCD, xcd = wgid % NXCD, off = wgid / NXCD; wgid = (xcd < r ? xcd * (q + 1) : r * (q + 1) + (xcd - r) * q) + off; }
        const int nig = WGM * nN, gid = wgid / nig, fm = gid * WGM, gsz = (nM - fm) < WGM ? (nM - fm) : WGM;
        u.pm = fm + ((wgid % nig) % gsz); u.pn = (wgid % nig) / gsz; return true;
    }
    __device__ __forceinline__ void a_ready(const Unit&) const {}
    __device__ __forceinline__ void done(const Unit&) const {}
};

__device__ __forceinline__ unsigned cvt_pk_bf16(float lo, float hi) { unsigned r; asm volatile("v_cvt_pk_bf16_f32 %0, %1, %2" : "=v"(r) : "v"(lo), "v"(hi)); return r; }

template <class Epi, class Sched, bool ALIGN_EPI = false, bool SP2 = false>
__device__ __forceinline__ void gemm_phase(PG8_LAS unsigned char* lds, const Gemm g, const Sched& S, const Epi& E) {
    const int tid = threadIdx.x, wid = __builtin_amdgcn_readfirstlane(tid >> 6), lane = tid & 63, wr = wid >> 2, wc = wid & 3, fr = lane & 15, fq = lane >> 4;
    const int K = g.K, nt = K / BK;
    unsigned voffA[2], voffB[2];
#pragma unroll
    for (int i = 0; i < 2; ++i) { int R, C; stage_rc(tid * 16 + i * 8192, R, C); const int Rb = Epi::PERM ? ((R & ~31) + perm32(R & 31)) : R;
        voffA[i] = (unsigned)(R * K + C) * 2u; voffB[i] = (unsigned)(Rb * K + C) * 2u; }
    const size_t kstep = (size_t)(BK * 2);
    const size_t hstep = (size_t)HALF * K * 2;
    const size_t tstep = 2 * hstep;
    const unsigned ldsw = (unsigned)wid * 1024u;
    const int aoff = lds_byte(wr * 64 + fr, fq * 8), boff = lds_byte(wc * 32 + fr, fq * 8);
#define PG8_SA(b, h) (((b) * 2 + (h)) * HTB)
#define PG8_SB(b, h) ((4 + (b) * 2 + (h)) * HTB)
#define PG8_STAGE(bufoff, gbase, voff) do { _Pragma("unroll") for (int _i = 0; _i < 2; ++_i) \
        __builtin_amdgcn_global_load_lds((const unsigned*)((const char*)(gbase) + (voff)[_i]), (PG8_LAS unsigned*)(lds + (bufoff) + ldsw + _i * 8192), 16, 0, 0); } while (0)
#define PG8_LDA(dst, b, h) do { _Pragma("unroll") for (int m = 0; m < 4; ++m) _Pragma("unroll") for (int k = 0; k < 2; ++k) dst[m][k] = *(const PG8_LAS bf16x8*)(lds + PG8_SA(b, h) + aoff + m * 2048 + k * 1024); } while (0)
#define PG8_LDB(dst, b, h) do { _Pragma("unroll") for (int n = 0; n < 2; ++n) _Pragma("unroll") for (int k = 0; k < 2; ++k) dst[n][k] = *(const PG8_LAS bf16x8*)(lds + PG8_SB(b, h) + boff + n * 2048 + k * 1024); } while (0)
#define PG8_MMA(ai, bj, At, Bt) do { __builtin_amdgcn_s_setprio(1); _Pragma("unroll") for (int m = 0; m < 4; ++m) _Pragma("unroll") for (int n = 0; n < 2; ++n) _Pragma("unroll") for (int k = 0; k < 2; ++k) \
        acc[ai][bj][m][n] = __builtin_amdgcn_mfma_f32_16x16x32_bf16(Bt[n][k], At[m][k], acc[ai][bj][m][n], 0, 0, 0); __builtin_amdgcn_s_setprio(0); } while (0)
#define PG8_WAIT_V(n) asm volatile("s_waitcnt vmcnt(" #n ")" ::: "memory")
#define PG8_WAIT_L(n) asm volatile("s_waitcnt lgkmcnt(" #n ")" ::: "memory")
#define PG8_BAR __builtin_amdgcn_s_barrier()
#define PG8_SCHED __builtin_amdgcn_sched_barrier(0)
    Unit cur, nxt; int ui = 0;
    if (!S.next(0, cur)) return;
    f32x4 acc[2][2][4][2];
#pragma unroll
    for (int a = 0; a < 2; ++a)
#pragma unroll
        for (int b = 0; b < 2; ++b)
#pragma unroll
            for (int m = 0; m < 4; ++m)
#pragma unroll
                for (int n = 0; n < 2; ++n) acc[a][b][m][n] = (f32x4){0.f, 0.f, 0.f, 0.f};
    bf16x8 At[4][2], B0[2][2], B1[2][2];
    const char* cA = (const char*)g.A + (size_t)cur.pm * tstep; const char* cB = (const char*)g.Bt + (size_t)cur.pn * tstep;
    S.a_ready(cur);
    if constexpr (SP2) {
        PG8_STAGE(PG8_SB(0, 0), cB, voffB); PG8_STAGE(PG8_SB(0, 1), cB + hstep, voffB); PG8_STAGE(PG8_SA(0, 0), cA, voffA); PG8_STAGE(PG8_SA(0, 1), cA + hstep, voffA);
        if (wr == 1) PG8_BAR;
        PG8_WAIT_V(2); PG8_BAR;
        PG8_STAGE(PG8_SB(1, 0), cB + kstep, voffB); PG8_STAGE(PG8_SA(1, 0), cA + kstep, voffA); PG8_STAGE(PG8_SB(1, 1), cB + hstep + kstep, voffB);
        PG8_WAIT_V(6); PG8_BAR;
    } else {
        PG8_STAGE(PG8_SB(0, 0), cB, voffB); PG8_STAGE(PG8_SA(0, 0), cA, voffA); PG8_STAGE(PG8_SB(0, 1), cB + hstep, voffB); PG8_STAGE(PG8_SA(0, 1), cA + hstep, voffA);
        if (wr == 1) PG8_BAR;
        PG8_WAIT_V(4); PG8_BAR;
        PG8_STAGE(PG8_SB(1, 0), cB + kstep, voffB); PG8_STAGE(PG8_SA(1, 0), cA + kstep, voffA); PG8_STAGE(PG8_SB(1, 1), cB + hstep + kstep, voffB);
        PG8_WAIT_V(6); PG8_BAR;
    }
    for (;;) {
        const bool has_next = S.next(ui + 1, nxt);
        const char* nA = has_next ? (const char*)g.A + (size_t)nxt.pm * tstep : cA; const char* nB = has_next ? (const char*)g.Bt + (size_t)nxt.pn * tstep : cB;
        for (int t = 0; t < nt; t += 2) {
            const bool last = (t == nt - 2);
            const char* a1 = cA + (size_t)(t + 1) * kstep;
            const char* a2 = last ? nA : cA + (size_t)(t + 2) * kstep; const char* b2 = last ? nB : cB + (size_t)(t + 2) * kstep;
            const char* a3 = a2 + kstep; const char* b3 = b2 + kstep;
            if (last && has_next) S.a_ready(nxt);
            if constexpr (SP2) {
            PG8_LDB(B0, 0, 0); PG8_LDB(B1, 0, 1); PG8_SCHED; PG8_LDA(At, 0, 0); PG8_STAGE(PG8_SA(1, 1), a1 + hstep, voffA);
            PG8_WAIT_V(8); PG8_WAIT_L(0); PG8_BAR; PG8_MMA(0, 0, At, B0); PG8_MMA(0, 1, At, B1); PG8_BAR; PG8_SCHED;
            PG8_LDA(At, 0, 1); PG8_STAGE(PG8_SB(0, 0), b2, voffB); PG8_STAGE(PG8_SB(0, 1), b2 + hstep, voffB); PG8_STAGE(PG8_SA(0, 0), a2, voffA);
            PG8_WAIT_V(8); PG8_WAIT_L(0); PG8_BAR; PG8_MMA(1, 0, At, B0); PG8_MMA(1, 1, At, B1); PG8_BAR; PG8_SCHED;
            PG8_LDB(B0, 1, 0); PG8_LDB(B1, 1, 1); PG8_SCHED; PG8_LDA(At, 1, 0); PG8_STAGE(PG8_SA(0, 1), a2 + hstep, voffA);
            PG8_WAIT_V(8); PG8_WAIT_L(0); PG8_BAR; PG8_MMA(0, 0, At, B0); PG8_MMA(0, 1, At, B1); PG8_BAR; PG8_SCHED;
            PG8_LDA(At, 1, 1); PG8_STAGE(PG8_SB(1, 0), b3, voffB); PG8_STAGE(PG8_SB(1, 1), b3 + hstep, voffB); PG8_STAGE(PG8_SA(1, 0), a3, voffA);
            PG8_WAIT_V(8); PG8_WAIT_L(0); PG8_BAR; PG8_MMA(1, 0, At, B0); PG8_MMA(1, 1, At, B1); PG8_BAR; PG8_SCHED;
            } else {
            PG8_LDB(B0, 0, 0); PG8_SCHED; PG8_LDA(At, 0, 0); PG8_STAGE(PG8_SA(1, 1), a1 + hstep, voffA);
            PG8_WAIT_L(8); PG8_BAR; PG8_WAIT_L(0); PG8_MMA(0, 0, At, B0); PG8_BAR; PG8_SCHED;
            PG8_LDB(B1, 0, 1); PG8_STAGE(PG8_SB(0, 0), b2, voffB);
            PG8_BAR; PG8_WAIT_L(0); PG8_MMA(0, 1, At, B1); PG8_BAR;
            PG8_LDA(At, 0, 1); PG8_STAGE(PG8_SA(0, 0), a2, voffA);
            PG8_BAR; PG8_WAIT_L(0); PG8_MMA(1, 0, At, B0); PG8_BAR; PG8_SCHED;
            PG8_STAGE(PG8_SB(0, 1), b2 + hstep, voffB);
            PG8_WAIT_V(6); PG8_BAR; PG8_MMA(1, 1, At, B1); PG8_BAR;
            PG8_LDB(B0, 1, 0); PG8_SCHED; PG8_LDA(At, 1, 0); PG8_STAGE(PG8_SA(0, 1), a2 + hstep, voffA);
            PG8_WAIT_L(8); PG8_BAR; PG8_WAIT_L(0); PG8_MMA(0, 0, At, B0); PG8_BAR; PG8_SCHED;
            PG8_LDB(B1, 1, 1); PG8_STAGE(PG8_SB(1, 0), b3, voffB);
            PG8_BAR; PG8_WAIT_L(0); PG8_MMA(0, 1, At, B1); PG8_BAR;
            PG8_LDA(At, 1, 1); PG8_STAGE(PG8_SA(1, 0), a3, voffA);
            PG8_BAR; PG8_WAIT_L(0); PG8_MMA(1, 0, At, B0); PG8_BAR; PG8_SCHED;
            PG8_STAGE(PG8_SB(1, 1), b3 + hstep, voffB);
            PG8_WAIT_V(6); PG8_BAR; PG8_MMA(1, 1, At, B1); PG8_BAR;
            }
        }
        if constexpr (ALIGN_EPI) { if (wr == 0) PG8_BAR; }
        if constexpr (!Epi::AFTER_DRAIN) { E(acc, cur, wr, wc, fr, fq); S.done(cur); }
        if (!has_next) break;
#pragma unroll
        for (int a = 0; a < 2; ++a)
#pragma unroll
            for (int b = 0; b < 2; ++b)
#pragma unroll
                for (int m = 0; m < 4; ++m)
#pragma unroll
                    for (int n = 0; n < 2; ++n) acc[a][b][m][n] = (f32x4){0.f, 0.f, 0.f, 0.f};
        cur = nxt; cA = nA; cB = nB; ++ui;
        if constexpr (ALIGN_EPI) { if (wr == 1) PG8_BAR; }
    }
    PG8_WAIT_V(0);
    if constexpr (!ALIGN_EPI) { if (wr == 0) PG8_BAR; }
    PG8_BAR;
    if constexpr (Epi::AFTER_DRAIN) { E.fused(acc, cur, wr, wc, fr, fq, lds, wid, lane); S.done(cur); }
#undef PG8_SA
#undef PG8_SB
#undef PG8_STAGE
#undef PG8_LDA
#undef PG8_LDB
#undef PG8_MMA
#undef PG8_WAIT_V
#undef PG8_WAIT_L
#undef PG8_BAR
#undef PG8_SCHED
}
}


using pg8::bf16_t;
using pg8::bf16x8;
using pg8::f32x4;
using pg8::u32x4;
#define LAS __attribute__((address_space(3)))
#define GAS __attribute__((address_space(1)))
typedef unsigned v4u __attribute__((ext_vector_type(4)));

#define NTOK 16384
#define SEQ 4096
#define DM 1024
#define NTHR 512
#define LDS_BYTES 147456
constexpr size_t MiB = (size_t)1 << 20;
constexpr size_t WS_CTL = 0, WS_WINT = 1, WS_PAT = 20, WS_PRT = 21, WS_WOT = 23;
constexpr size_t WS_KA = 26, WS_VA = 74, WS_QR = 122, WS_KR = 138, WS_VR = 154, WS_QA = 186, WS_GSW = 234, WS_GA = 266, WS_END = 298;
constexpr size_t WS_OATTN = 1;
constexpr size_t WS_Y = 26, WS_ORET = 90;
constexpr size_t WS_X1 = 122;
constexpr size_t WS_MERGED = 186;
constexpr size_t WS_ROUTE = 17;
constexpr size_t WS_WGU = 26, WS_WD = 90;
constexpr size_t WS_XS = 186;
constexpr size_t WS_Y01 = 186;
constexpr size_t R_WGCNT = 0, R_TOKE = 65536, R_TOKRANK = 196608, R_TOKW = 327680, R_RSTD = 458752, R_SLOTTOK = 524288, R_SLOTW = 720896;
constexpr int LDS_MOE = 131072;

__device__ __forceinline__ bf16_t f2bf(float f) { unsigned u = __float_as_uint(f); return (bf16_t)((u + 0x7fffu + ((u >> 16) & 1u)) >> 16); }
__device__ __forceinline__ unsigned pk2(float lo, float hi) { return (unsigned)f2bf(lo) | ((unsigned)f2bf(hi) << 16); }
__device__ __forceinline__ float bf2f(bf16_t h) { return __uint_as_float(((unsigned)h) << 16); }
__device__ __forceinline__ float bflo(unsigned w) { return __uint_as_float(w << 16); }
__device__ __forceinline__ float bfhi(unsigned w) { return __uint_as_float(w & 0xffff0000u); }
__device__ __forceinline__ float wave_sum(float v) {
#pragma unroll
    for (int o = 32; o >= 1; o >>= 1) v += __shfl_xor(v, o);
    return v;
}
__device__ __forceinline__ float sigmoidf_fast(float g) { return __builtin_amdgcn_rcpf(1.0f + __expf(-g)); }
#define LDS_WAIT() asm volatile("s_waitcnt lgkmcnt(0)" ::: "memory")

struct Params {
    const float *x, *g_mix, *w_in, *w_ab, *w_rb, *w_out, *g_ffn, *w_gr, *b_gr, *w_er, *b_er, *w_gate, *w_up, *w_down, *g_final;
    float* out; char* ws; char* ob;
};

__device__ __forceinline__ float block_sum512(float v, float* red) {
    v = wave_sum(v);
    __syncthreads();
    if ((threadIdx.x & 63) == 0) red[threadIdx.x >> 6] = v;
    __syncthreads();
    float s = 0.f;
#pragma unroll
    for (int i = 0; i < 8; ++i) s += red[i];
    return s;
}

template <bool GU>
__device__ __forceinline__ void p0_transpose_item(const float* W, int K, int N, bf16_t* WT, int row_off, LAS float* scr, int item, int lane) {
    const int nblk = N / 32, kb = item / nblk, nb = item % nblk, k0 = 64 * kb, n0 = 32 * nb;
#pragma unroll 8
    for (int i = 0; i < 32; ++i) { const int kk = 2 * i + (lane >> 5); scr[kk * 33 + (lane & 31)] = W[(size_t)(k0 + kk) * N + n0 + (lane & 31)]; }
    LDS_WAIT(); asm volatile("" ::: "memory");
    const int c = lane & 7;
#pragma unroll
    for (int j = 0; j < 4; ++j) { const int n = (lane >> 3) + 8 * j; const LAS float* s = scr + (8 * c) * 33 + n;
        v4u o; o.x = pk2(s[0 * 33], s[1 * 33]); o.y = pk2(s[2 * 33], s[3 * 33]); o.z = pk2(s[4 * 33], s[5 * 33]); o.w = pk2(s[6 * 33], s[7 * 33]);
        const int drow = GU ? ((((n0 + n) >> 2) << 3) + ((n0 + n) & 3) + row_off) : (row_off + n0 + n);
        *(GAS v4u*)(WT + (size_t)drow * K + k0 + 8 * c) = o; }
    LDS_WAIT(); asm volatile("" ::: "memory");
}
__device__ __forceinline__ void ph_transpose_all(const float* W, int K, int N, int nmat, bf16_t* WT, LAS unsigned char* lds) {
    const int wave = threadIdx.x >> 6, lane = threadIdx.x & 63;
    LAS float* scr = (LAS float*)(lds + wave * 16384);
    const int gw = blockIdx.x * 8 + wave, NGW = gridDim.x * 8;
    const int per = (K / 64) * (N / 32), total = per * nmat;
    for (int it = gw; it < total; it += NGW) {
        const int mi = it / per, r = it % per;
        p0_transpose_item<false>(W + (size_t)mi * K * N, K, N, WT + (size_t)mi * K * N, 0, scr, r, lane);
    }
}
__device__ __forceinline__ void ph_transpose_gu(const float* Wg, const float* Wu, bf16_t* WT, LAS unsigned char* lds) {
    const int wave = threadIdx.x >> 6, lane = threadIdx.x & 63;
    LAS float* scr = (LAS float*)(lds + wave * 16384);
    const int gw = blockIdx.x * 8 + wave, NGW = gridDim.x * 8;
    const int per = (1024 / 64) * (512 / 32), total = per * 64;
    for (int it = gw; it < total; it += NGW) {
        const int mi = it / per, r = it % per, e = mi >> 1, up = mi & 1;
        p0_transpose_item<true>((up ? Wu : Wg) + (size_t)e * 1024 * 512, 1024, 512, WT + (size_t)e * 1024 * 1024, up * 4, scr, r, lane);
    }
}

__device__ __forceinline__ void ph_rmsnorm_bf16(const float* __restrict__ x, const float* __restrict__ g, bf16_t* __restrict__ out) {
    const int lane = threadIdx.x & 63, gw = blockIdx.x * 8 + (threadIdx.x >> 6), ngw = gridDim.x * 8;
    for (int row = gw; row < NTOK; row += ngw) {
        float4 v[4]; float ss = 0.f;
#pragma unroll
        for (int j = 0; j < 4; ++j) { v[j] = ((const float4*)(x + (size_t)row * DM))[lane + 64 * j]; ss += v[j].x * v[j].x + v[j].y * v[j].y + v[j].z * v[j].z + v[j].w * v[j].w; }
        ss = wave_sum(ss);
        const float r = rsqrtf(ss * (1.0f / DM) + 1e-6f);
#pragma unroll
        for (int j = 0; j < 4; ++j) {
            const float4 gg = ((const float4*)g)[lane + 64 * j];
            uint2 o; o.x = pk2(v[j].x * r * gg.x, v[j].y * r * gg.y); o.y = pk2(v[j].z * r * gg.z, v[j].w * r * gg.w);
            ((uint2*)(out + (size_t)row * DM))[lane + 64 * j] = o;
        }
    }
}

struct EpiProj {
    static constexpr bool PERM = true, AFTER_DRAIN = false;
    char* ws; char* ob;
    __device__ __forceinline__ void operator()(const f32x4 (&acc)[2][2][4][2], const pg8::Unit& u, int wr, int wc, int fr, int fq) const {
        const int pn = u.pn;
        size_t off; int w, t0;
        if (pn < 6) { off = WS_QA * MiB; w = 1536; t0 = 0; }
        else if (pn < 12) { off = WS_KA * MiB; w = 1536; t0 = 6; }
        else if (pn < 18) { off = WS_VA * MiB; w = 1536; t0 = 12; }
        else if (pn < 20) { off = WS_QR * MiB; w = 512; t0 = 18; }
        else if (pn < 22) { off = WS_KR * MiB; w = 512; t0 = 20; }
        else if (pn < 26) { off = WS_VR * MiB; w = 1024; t0 = 22; }
        else if (pn < 30) { off = WS_GSW * MiB; w = 1024; t0 = 26; }
        else if (pn < 34) { off = WS_GA * MiB; w = 1024; t0 = 30; }
        else { off = 32 * MiB; w = 1024; t0 = 34; }
        bf16_t* base = (bf16_t*)((pn >= 34 ? ob : ws) + off);
        const int row0 = u.pm * 256 + wr * 64 + fr, col0 = (pn - t0) * 256 + wc * 32 + 8 * fq;
#pragma unroll
        for (int ai = 0; ai < 2; ++ai)
#pragma unroll
            for (int m = 0; m < 4; ++m) {
                bf16_t* rowp = base + (size_t)(row0 + ai * 128 + m * 16) * w + col0;
#pragma unroll
                for (int bj = 0; bj < 2; ++bj) {
                    const f32x4 v0 = acc[ai][bj][m][0], v1 = acc[ai][bj][m][1];
                    u32x4 o; o.x = pk2(v0[0], v0[1]); o.y = pk2(v0[2], v0[3]); o.z = pk2(v1[0], v1[1]); o.w = pk2(v1[2], v1[3]);
                    *(u32x4*)(rowp + bj * 128) = o;
                }
            }
    }
};
struct EpiGate {
    static constexpr bool PERM = true, AFTER_DRAIN = false;
    const bf16_t* gate; bf16_t* merged; int accumulate;
    __device__ __forceinline__ void operator()(const f32x4 (&acc)[2][2][4][2], const pg8::Unit& u, int wr, int wc, int fr, int fq) const {
        const int row0 = u.pm * 256 + wr * 64 + fr, col0 = u.pn * 256 + wc * 32 + 8 * fq;
#pragma unroll
        for (int ai = 0; ai < 2; ++ai)
#pragma unroll
            for (int m = 0; m < 4; ++m)
#pragma unroll
                for (int bj = 0; bj < 2; ++bj) {
                    const size_t idx = (size_t)(row0 + ai * 128 + m * 16) * 1024 + col0 + bj * 128;
                    const u32x4 g = *(const u32x4*)(gate + idx);
                    const f32x4 v0 = acc[ai][bj][m][0], v1 = acc[ai][bj][m][1];
                    float o[8];
                    o[0] = v0[0] * sigmoidf_fast(bflo(g.x)); o[1] = v0[1] * sigmoidf_fast(bfhi(g.x));
                    o[2] = v0[2] * sigmoidf_fast(bflo(g.y)); o[3] = v0[3] * sigmoidf_fast(bfhi(g.y));
                    o[4] = v1[0] * sigmoidf_fast(bflo(g.z)); o[5] = v1[1] * sigmoidf_fast(bfhi(g.z));
                    o[6] = v1[2] * sigmoidf_fast(bflo(g.w)); o[7] = v1[3] * sigmoidf_fast(bfhi(g.w));
                    if (accumulate) {
                        const u32x4 p = *(const u32x4*)(merged + idx);
                        o[0] += bflo(p.x); o[1] += bfhi(p.x); o[2] += bflo(p.y); o[3] += bfhi(p.y);
                        o[4] += bflo(p.z); o[5] += bfhi(p.z); o[6] += bflo(p.w); o[7] += bfhi(p.w);
                    }
                    u32x4 w; w.x = pk2(o[0], o[1]); w.y = pk2(o[2], o[3]); w.z = pk2(o[4], o[5]); w.w = pk2(o[6], o[7]);
                    *(u32x4*)(merged + idx) = w;
                }
    }
};
struct EpiResid {
    static constexpr bool PERM = true, AFTER_DRAIN = false;
    const float* x; float* x1;
    __device__ __forceinline__ void operator()(const f32x4 (&acc)[2][2][4][2], const pg8::Unit& u, int wr, int wc, int fr, int fq) const {
        const int row0 = u.pm * 256 + wr * 64 + fr, col0 = u.pn * 256 + wc * 32 + 8 * fq;
#pragma unroll
        for (int ai = 0; ai < 2; ++ai)
#pragma unroll
            for (int m = 0; m < 4; ++m)
#pragma unroll
                for (int bj = 0; bj < 2; ++bj) {
                    const size_t idx = (size_t)(row0 + ai * 128 + m * 16) * 1024 + col0 + bj * 128;
                    const f32x4 a = *(const f32x4*)(x + idx), b = *(const f32x4*)(x + idx + 4);
                    *(f32x4*)(x1 + idx) = a + acc[ai][bj][m][0];
                    *(f32x4*)(x1 + idx + 4) = b + acc[ai][bj][m][1];
                }
    }
};

__device__ __forceinline__ void ph_attn_naive(const bf16_t* __restrict__ qa, const bf16_t* __restrict__ ka, const bf16_t* __restrict__ va, bf16_t* __restrict__ oattn) {
  for (int idx = blockIdx.x * NTHR + threadIdx.x; idx < NTOK * 8; idx += gridDim.x * NTHR) {
    const int h = idx & 7, t = (idx >> 3) & (SEQ - 1), b = idx >> 15;
    const float slope = exp2f(-(float)(h + 1));
    float m = -1e30f, l = 0.f, o[64];
#pragma unroll
    for (int c = 0; c < 64; ++c) o[c] = 0.f;
    for (int g = 0; g < 3; ++g) {
        const int d = (g == 0) ? 1 : (g == 1 ? 4 : 16);
        float q[64];
        const bf16_t* qp = qa + (size_t)(b * SEQ + t) * 1536 + g * 512 + h * 64;
#pragma unroll
        for (int c = 0; c < 64; ++c) q[c] = bf2f(qp[c]) * 0.125f;
        for (int j = 0; j <= 128; ++j) {
            const int p = t - j * d;
            if (p < 0) break;
            const size_t off = (size_t)(b * SEQ + p) * 1536 + g * 512 + h * 64;
            const bf16_t* kp = ka + off; const bf16_t* vp = va + off;
            float s = 0.f;
#pragma unroll
            for (int c = 0; c < 64; ++c) s += q[c] * bf2f(kp[c]);
            s -= slope * (float)(j * d);
            const float mn = fmaxf(m, s);
            const float a = __expf(m - mn), pw = __expf(s - mn);
            l = l * a + pw;
#pragma unroll
            for (int c = 0; c < 64; ++c) o[c] = o[c] * a + pw * bf2f(vp[c]);
            m = mn;
        }
    }
    const float inv = 1.0f / l;
    bf16_t* op = oattn + (size_t)(b * SEQ + t) * 512 + h * 64;
#pragma unroll
    for (int c = 0; c < 64; ++c) op[c] = f2bf(o[c] * inv);
  }
}

__device__ __forceinline__ void ph_ret_naive(const bf16_t* __restrict__ qr, const bf16_t* __restrict__ kr, const bf16_t* __restrict__ vr, float* __restrict__ y) {
    for (int unit = blockIdx.x; unit < 128; unit += gridDim.x) {
        const int bh = unit >> 3, sl = unit & 7;
        const int b = bh >> 2, h = bh & 3;
        const int wid = threadIdx.x >> 6, lane = threadIdx.x & 63;
        const int kg = lane & 15, dv = sl * 32 + wid * 4 + (lane >> 4);
        const float gamma = 1.0f - exp2f(-5.0f - (float)h);
        const float ksc = 0.08838834764831845f;
        float S[8];
#pragma unroll
        for (int i = 0; i < 8; ++i) S[i] = 0.f;
        for (int t = 0; t < SEQ; ++t) {
            const size_t row = (size_t)b * SEQ + t;
            const bf16x8 qv = *(const bf16x8*)(qr + row * 512 + h * 128 + kg * 8);
            const bf16x8 kv = *(const bf16x8*)(kr + row * 512 + h * 128 + kg * 8);
            const float v = bf2f(vr[row * 1024 + h * 256 + dv]);
            float part = 0.f;
#pragma unroll
            for (int i = 0; i < 8; ++i) {
                S[i] = gamma * S[i] + (bf2f((bf16_t)kv[i]) * ksc) * v;
                part += bf2f((bf16_t)qv[i]) * S[i];
            }
            part += __shfl_xor(part, 1); part += __shfl_xor(part, 2); part += __shfl_xor(part, 4); part += __shfl_xor(part, 8);
            if (kg == 0) y[row * 1024 + h * 256 + dv] = part;
        }
    }
}

__device__ __forceinline__ void ph_groupnorm_swish(const float* __restrict__ y, const bf16_t* __restrict__ gsw, bf16_t* __restrict__ oret) {
    const int lane = threadIdx.x & 63, gw = blockIdx.x * 8 + (threadIdx.x >> 6), ngw = gridDim.x * 8;
    for (int it = gw; it < NTOK * 4; it += ngw) {
        const size_t base = (size_t)it * 256 + lane * 4;
        const float4 v = *(const float4*)(y + base);
        const float mu = wave_sum(v.x + v.y + v.z + v.w) * (1.0f / 256.0f);
        const float dx = v.x - mu, dy = v.y - mu, dz = v.z - mu, dw = v.w - mu;
        const float var = wave_sum(dx * dx + dy * dy + dz * dz + dw * dw) * (1.0f / 256.0f);
        const float r = rsqrtf(var + 1e-6f);
        const ushort4 gs = *(const ushort4*)(gsw + base);
        const float g0 = bf2f(gs.x), g1 = bf2f(gs.y), g2 = bf2f(gs.z), g3 = bf2f(gs.w);
        ushort4 o;
        o.x = f2bf(g0 / (1.0f + __expf(-g0)) * dx * r);
        o.y = f2bf(g1 / (1.0f + __expf(-g1)) * dy * r);
        o.z = f2bf(g2 / (1.0f + __expf(-g2)) * dz * r);
        o.w = f2bf(g3 / (1.0f + __expf(-g3)) * dw * r);
        *(ushort4*)(oret + base) = o;
    }
}


__device__ __forceinline__ void ph_route(const Params& p, const float* __restrict__ x1, char* route, LAS unsigned char* lds) {
    LAS float* logits = (LAS float*)lds;
    LAS int* sel_e = (LAS int*)(lds + 12288);
    LAS float* sel_w = (LAS float*)(lds + 12288 + 512);
    const int t = threadIdx.x, wid = t >> 6, lane = t & 63, c = lane & 15, q = lane >> 4;
    int* wgcnt = (int*)(route + R_WGCNT); int* tok_e = (int*)(route + R_TOKE); int* tok_rank = (int*)(route + R_TOKRANK);
    float* tok_w = (float*)(route + R_TOKW); float* rstd_o = (float*)(route + R_RSTD);
    for (int grp = blockIdx.x; grp < NTOK / 64; grp += gridDim.x) {
        const int tok0 = grp * 64;
        __syncthreads();
        if (wid < 4) {
            const int tok = tok0 + wid * 16 + c;
            f32x4 a0 = {0.f, 0.f, 0.f, 0.f}, a1 = a0, a2 = a0; float ssq = 0.f;
            const float* xr = x1 + (size_t)tok * DM + 4 * q;
            for (int k0 = 0; k0 < DM; k0 += 16) {
                const float4 xa = *(const float4*)(xr + k0);
                const float4 gg = *(const float4*)(p.g_ffn + k0 + 4 * q);
                ssq += xa.x * xa.x + xa.y * xa.y + xa.z * xa.z + xa.w * xa.w;
                const float av[4] = {xa.x * gg.x, xa.y * gg.y, xa.z * gg.z, xa.w * gg.w};
#pragma unroll
                for (int i = 0; i < 4; ++i) {
                    const int k = k0 + 4 * q + i;
                    const float b0 = p.w_er[k * 32 + c], b1 = p.w_er[k * 32 + 16 + c], b2 = (c < 4) ? p.w_gr[k * 4 + c] : 0.f;
                    a0 = __builtin_amdgcn_mfma_f32_16x16x4f32(av[i], b0, a0, 0, 0, 0);
                    a1 = __builtin_amdgcn_mfma_f32_16x16x4f32(av[i], b1, a1, 0, 0, 0);
                    a2 = __builtin_amdgcn_mfma_f32_16x16x4f32(av[i], b2, a2, 0, 0, 0);
                }
            }
            ssq += __shfl_xor(ssq, 16); ssq += __shfl_xor(ssq, 32);
            const float rstd = rsqrtf(ssq * (1.0f / DM) + 1e-6f);
            if (q == 0) rstd_o[tok] = rstd;
            const float be0 = p.b_er[c], be1 = p.b_er[16 + c], bg = (c < 4) ? p.b_gr[c] : 0.f;
#pragma unroll
            for (int reg = 0; reg < 4; ++reg) {
                const int r = 4 * q + reg;
                const float rs = __shfl(rstd, r);
                LAS float* lp = logits + (wid * 16 + r) * 48;
                lp[c] = a0[reg] * rs + be0; lp[16 + c] = a1[reg] * rs + be1;
                if (c < 4) lp[32 + c] = a2[reg] * rs + bg;
            }
        }
        __syncthreads();
        if (t < 64) {
            const LAS float* lp = logits + t * 48;
            int gi = 0; float mx = lp[32];
            for (int j = 1; j < 4; ++j) if (lp[32 + j] > mx) { mx = lp[32 + j]; gi = j; }
            float sum = 0.f;
            for (int j = 0; j < 4; ++j) sum += __expf(lp[32 + j] - mx);
            const float gval = 1.0f / sum;
            const LAS float* el = lp + gi * 8;
            int i1 = 0; float v1 = el[0];
            for (int j = 1; j < 8; ++j) if (el[j] > v1) { v1 = el[j]; i1 = j; }
            int i2 = 0; float v2 = -3.0e38f;
            for (int j = 0; j < 8; ++j) if (j != i1 && el[j] > v2) { v2 = el[j]; i2 = j; }
            const float e2 = __expf(v2 - v1);
            sel_e[2 * t] = gi * 8 + i1; sel_e[2 * t + 1] = gi * 8 + i2;
            sel_w[2 * t] = gval / (1.0f + e2); sel_w[2 * t + 1] = gval * e2 / (1.0f + e2);
        }
        __syncthreads();
        if (t < 128) {
            const int e = sel_e[t]; int rank = 0;
            for (int j = 0; j < t; ++j) rank += (sel_e[j] == e) ? 1 : 0;
            tok_e[tok0 * 2 + t] = e; tok_rank[tok0 * 2 + t] = rank; tok_w[tok0 * 2 + t] = sel_w[t];
        } else if (t < 160) {
            const int e = t - 128; int cnt = 0;
            for (int j = 0; j < 128; ++j) cnt += (sel_e[j] == e) ? 1 : 0;
            wgcnt[grp * 32 + e] = cnt;
        }
    }
}
__device__ __forceinline__ void moe_tables(const char* route, LAS unsigned char* lds) {
    LAS int* tstart = (LAS int*)(lds + LDS_MOE); LAS int* tot = tstart + 64;
    const int* wgcnt = (const int*)(route + R_WGCNT);
    const int t = threadIdx.x;
    if (t < 32) { int s = 0; for (int g = 0; g < NTOK / 64; ++g) s += wgcnt[g * 32 + t]; tot[t] = s; }
    __syncthreads();
    if (t == 0) { int acc = 0; for (int e = 0; e < 32; ++e) { tstart[e] = acc; acc += (tot[e] + 255) >> 8; } tstart[32] = acc; }
    __syncthreads();
}
__device__ __forceinline__ void ph_gather(const Params& p, const float* __restrict__ x1, char* route, bf16_t* xs, LAS unsigned char* lds) {
    LAS int* tstart = (LAS int*)(lds + LDS_MOE); LAS int* bef = tstart + 128;
    const int* wgcnt = (const int*)(route + R_WGCNT); const int* tok_e = (const int*)(route + R_TOKE); const int* tok_rank = (const int*)(route + R_TOKRANK);
    const float* tok_w = (const float*)(route + R_TOKW); const float* rstd_i = (const float*)(route + R_RSTD);
    int* slot_tok = (int*)(route + R_SLOTTOK); float* slot_w = (float*)(route + R_SLOTW);
    const int t = threadIdx.x, wid = t >> 6, lane = t & 63;
    moe_tables(route, lds);
    for (int grp = blockIdx.x; grp < NTOK / 64; grp += gridDim.x) {
        __syncthreads();
        if (t < 32) { int s = 0; for (int g = 0; g < grp; ++g) s += wgcnt[g * 32 + t]; bef[t] = s; }
        __syncthreads();
        for (int j = wid; j < 128; j += 8) {
            const int tok = grp * 64 + (j >> 1), ch = j & 1;
            const int e = tok_e[tok * 2 + ch];
            const int slot = tstart[e] * 256 + bef[e] + tok_rank[tok * 2 + ch];
            const float rs = rstd_i[tok];
#pragma unroll
            for (int jj = 0; jj < 4; ++jj) {
                const float4 v = ((const float4*)(x1 + (size_t)tok * DM))[lane + 64 * jj];
                const float4 gg = ((const float4*)p.g_ffn)[lane + 64 * jj];
                uint2 o; o.x = pk2(v.x * rs * gg.x, v.y * rs * gg.y); o.y = pk2(v.z * rs * gg.z, v.w * rs * gg.w);
                ((uint2*)(xs + (size_t)slot * DM))[lane + 64 * jj] = o;
            }
            if (lane == 0) { slot_tok[slot] = ch * NTOK + tok; slot_w[slot] = tok_w[tok * 2 + ch]; }
        }
    }
}
struct MoeOrder {
    const LAS int* tstart; int G, c, nunits;
    __device__ __forceinline__ bool next(int i, pg8::Unit& u) const {
        const long L = (long)i * G + c; if (L >= nunits) return false;
        const int T = (int)(L >> 2), nt = (int)(L & 3); int e = 0;
        for (int j = 1; j < 32; ++j) e += (tstart[j] <= T) ? 1 : 0;
        u.pm = T; u.pn = e * 4 + nt; return true;
    }
    __device__ __forceinline__ void a_ready(const pg8::Unit&) const {}
    __device__ __forceinline__ void done(const pg8::Unit&) const {}
};
struct EpiMoe1 {
    static constexpr bool PERM = true, AFTER_DRAIN = false;
    bf16_t* hid; const float* slot_w;
    __device__ __forceinline__ void operator()(const f32x4 (&acc)[2][2][4][2], const pg8::Unit& u, int wr, int wc, int fr, int fq) const {
        const int row0 = u.pm * 256 + wr * 64 + fr, f0 = (u.pn & 3) * 128 + wc * 16 + 4 * fq;
#pragma unroll
        for (int ai = 0; ai < 2; ++ai)
#pragma unroll
            for (int m = 0; m < 4; ++m) {
                const int row = row0 + ai * 128 + m * 16;
                const float w = slot_w[row];
#pragma unroll
                for (int bj = 0; bj < 2; ++bj) {
                    const f32x4 g = acc[ai][bj][m][0], up = acc[ai][bj][m][1];
                    float o[4];
#pragma unroll
                    for (int i = 0; i < 4; ++i) o[i] = g[i] * sigmoidf_fast(g[i]) * up[i] * w;
                    uint2 pk; pk.x = pk2(o[0], o[1]); pk.y = pk2(o[2], o[3]);
                    *(uint2*)(hid + (size_t)row * 512 + f0 + bj * 64) = pk;
                }
            }
    }
};
struct EpiMoe2 {
    static constexpr bool PERM = true, AFTER_DRAIN = false;
    bf16_t* y01; const int* slot_tok; const LAS int* tstart; const LAS int* tot;
    __device__ __forceinline__ void operator()(const f32x4 (&acc)[2][2][4][2], const pg8::Unit& u, int wr, int wc, int fr, int fq) const {
        const int e = u.pn >> 2, nvalid = tot[e] - (u.pm - tstart[e]) * 256;
        const int lrow0 = wr * 64 + fr, col0 = (u.pn & 3) * 256 + wc * 32 + 8 * fq;
#pragma unroll
        for (int ai = 0; ai < 2; ++ai)
#pragma unroll
            for (int m = 0; m < 4; ++m) {
                const int lrow = lrow0 + ai * 128 + m * 16;
                if (lrow < nvalid) {
                    const int dst = slot_tok[u.pm * 256 + lrow];
                    bf16_t* rowp = y01 + (size_t)dst * 1024 + col0;
#pragma unroll
                    for (int bj = 0; bj < 2; ++bj) {
                        const f32x4 v0 = acc[ai][bj][m][0], v1 = acc[ai][bj][m][1];
                        u32x4 o; o.x = pk2(v0[0], v0[1]); o.y = pk2(v0[2], v0[3]); o.z = pk2(v1[0], v1[1]); o.w = pk2(v1[2], v1[3]);
                        *(u32x4*)(rowp + bj * 128) = o;
                    }
                }
            }
    }
};
__device__ __forceinline__ void ph_final(const float* __restrict__ x1, const bf16_t* __restrict__ y01, const float* __restrict__ g, float* __restrict__ out) {
    const int lane = threadIdx.x & 63, gw = blockIdx.x * 8 + (threadIdx.x >> 6), ngw = gridDim.x * 8;
    for (int row = gw; row < NTOK; row += ngw) {
        float4 v[4]; float ss = 0.f;
#pragma unroll
        for (int j = 0; j < 4; ++j) {
            v[j] = ((const float4*)(x1 + (size_t)row * DM))[lane + 64 * j];
            const uint2 a = ((const uint2*)(y01 + (size_t)row * DM))[lane + 64 * j];
            const uint2 b = ((const uint2*)(y01 + (size_t)(NTOK + row) * DM))[lane + 64 * j];
            v[j].x += bflo(a.x) + bflo(b.x); v[j].y += bfhi(a.x) + bfhi(b.x); v[j].z += bflo(a.y) + bflo(b.y); v[j].w += bfhi(a.y) + bfhi(b.y);
            ss += v[j].x * v[j].x + v[j].y * v[j].y + v[j].z * v[j].z + v[j].w * v[j].w;
        }
        ss = wave_sum(ss);
        const float r = rsqrtf(ss * (1.0f / DM) + 1e-6f);
#pragma unroll
        for (int j = 0; j < 4; ++j) {
            const float4 gg = ((const float4*)g)[lane + 64 * j];
            float4 o; o.x = v[j].x * r * gg.x; o.y = v[j].y * r * gg.y; o.z = v[j].z * r * gg.z; o.w = v[j].w * r * gg.w;
            ((float4*)(out + (size_t)row * DM))[lane + 64 * j] = o;
        }
    }
}

__global__ void __launch_bounds__(NTHR, 2) fwd_megakernel(Params p) {
    extern __shared__ __attribute__((aligned(16))) unsigned char lds_raw[];
    LAS unsigned char* lds = (LAS unsigned char*)lds_raw;
    cg::grid_group grid = cg::this_grid();
    char* ws = p.ws; char* ob = p.ob;
    bf16_t* WinT = (bf16_t*)(ws + WS_WINT * MiB);
    bf16_t* PAt = (bf16_t*)(ws + WS_PAT * MiB);
    bf16_t* PRt = (bf16_t*)(ws + WS_PRT * MiB);
    bf16_t* WoT = (bf16_t*)(ws + WS_WOT * MiB);
    bf16_t* qa = (bf16_t*)(ws + WS_QA * MiB);
    bf16_t* ka = (bf16_t*)(ws + WS_KA * MiB);
    bf16_t* va = (bf16_t*)(ws + WS_VA * MiB);
    bf16_t* qr = (bf16_t*)(ws + WS_QR * MiB);
    bf16_t* kr = (bf16_t*)(ws + WS_KR * MiB);
    bf16_t* vr = (bf16_t*)(ws + WS_VR * MiB);
    bf16_t* gsw = (bf16_t*)(ws + WS_GSW * MiB);
    bf16_t* ga = (bf16_t*)(ws + WS_GA * MiB);
    bf16_t* oattn = (bf16_t*)(ws + WS_OATTN * MiB);
    bf16_t* hb = (bf16_t*)(ob + 0 * MiB);
    bf16_t* gr = (bf16_t*)(ob + 32 * MiB);
    float* y = (float*)(ws + WS_Y * MiB);
    bf16_t* oret = (bf16_t*)(ws + WS_ORET * MiB);
    bf16_t* merged = (bf16_t*)(ws + WS_MERGED * MiB);
    float* x1 = (float*)(ws + WS_X1 * MiB);
    const int G = gridDim.x;

    ph_transpose_all(p.w_in, 1024, 9728, 1, WinT, lds);
    ph_transpose_all(p.w_ab, 512, 1024, 1, PAt, lds);
    ph_transpose_all(p.w_rb, 1024, 1024, 1, PRt, lds);
    ph_transpose_all(p.w_out, 1024, 1024, 1, WoT, lds);
    ph_rmsnorm_bf16(p.x, p.g_mix, hb);
    grid.sync();
    {
        pg8::Gemm g{hb, WinT, NTOK, 9728, 1024}; pg8::StaticOrder S; S.init(NTOK, 9728, G, (int)blockIdx.x);
        EpiProj E{ws, ob};
        pg8::gemm_phase<EpiProj, pg8::StaticOrder, true, true>(lds, g, S, E);
    }
    grid.sync();
    ph_attn_naive(qa, ka, va, oattn);
    grid.sync();
    ph_ret_naive(qr, kr, vr, y);
    grid.sync();
    ph_groupnorm_swish(y, gsw, oret);
    grid.sync();
    {
        pg8::Gemm g{oattn, PAt, NTOK, 1024, 512}; pg8::StaticOrder S; S.init(NTOK, 1024, G, (int)blockIdx.x);
        EpiGate E{ga, merged, 0};
        pg8::gemm_phase<EpiGate, pg8::StaticOrder, true, true>(lds, g, S, E);
    }
    {
        pg8::Gemm g{oret, PRt, NTOK, 1024, 1024}; pg8::StaticOrder S; S.init(NTOK, 1024, G, (int)blockIdx.x);
        EpiGate E{gr, merged, 1};
        pg8::gemm_phase<EpiGate, pg8::StaticOrder, true, true>(lds, g, S, E);
    }
    grid.sync();
    {
        pg8::Gemm g{merged, WoT, NTOK, 1024, 1024}; pg8::StaticOrder S; S.init(NTOK, 1024, G, (int)blockIdx.x);
        EpiResid E{p.x, x1};
        pg8::gemm_phase<EpiResid, pg8::StaticOrder, true, true>(lds, g, S, E);
    }
    grid.sync();
    char* route = ws + WS_ROUTE * MiB;
    bf16_t* WguT = (bf16_t*)(ws + WS_WGU * MiB);
    bf16_t* WdT = (bf16_t*)(ws + WS_WD * MiB);
    bf16_t* xs = (bf16_t*)(ws + WS_XS * MiB);
    bf16_t* y01 = (bf16_t*)(ws + WS_Y01 * MiB);
    bf16_t* hid = (bf16_t*)(ob);
    ph_transpose_gu(p.w_gate, p.w_up, WguT, lds);
    ph_transpose_all(p.w_down, 512, 1024, 32, WdT, lds);
    ph_route(p, x1, route, lds);
    grid.sync();
    ph_gather(p, x1, route, xs, lds);
    grid.sync();
    const LAS int* tstart = (const LAS int*)(lds + LDS_MOE); const LAS int* tot = tstart + 64;
    {
        pg8::Gemm g{xs, WguT, 40960, 32 * 1024, 1024}; MoeOrder S{tstart, G, (int)blockIdx.x, tstart[32] * 4};
        EpiMoe1 E{hid, (const float*)(route + R_SLOTW)};
        pg8::gemm_phase<EpiMoe1, MoeOrder, true, true>(lds, g, S, E);
    }
    grid.sync();
    {
        pg8::Gemm g{hid, WdT, 40960, 32 * 1024, 512}; MoeOrder S{tstart, G, (int)blockIdx.x, tstart[32] * 4};
        EpiMoe2 E{y01, (const int*)(route + R_SLOTTOK), tstart, tot};
        pg8::gemm_phase<EpiMoe2, MoeOrder, true, true>(lds, g, S, E);
    }
    grid.sync();
    ph_final(x1, y01, p.g_final, p.out);
}

extern "C" void kernel_launch(void* const* d_in, const int* in_sizes, int n_in, void* d_out, int out_size, void* d_ws, size_t ws_size, hipStream_t stream) {
    static int grid_blocks = 0;
    if (!grid_blocks) {
        int dev = 0, cus = 0, per_cu = 0;
        (void)hipGetDevice(&dev);
        (void)hipDeviceGetAttribute(&cus, hipDeviceAttributeMultiprocessorCount, dev);
        (void)hipFuncSetAttribute((const void*)fwd_megakernel, hipFuncAttributeMaxDynamicSharedMemorySize, LDS_BYTES);
        (void)hipOccupancyMaxActiveBlocksPerMultiprocessor(&per_cu, (const void*)fwd_megakernel, NTHR, LDS_BYTES);
        if (per_cu > 1) per_cu = 1;
        grid_blocks = cus * per_cu;
        if (grid_blocks <= 0 || ws_size < WS_END * MiB) { fprintf(stderr, "kernel_launch: cannot launch (grid %d, ws %zu)\n", grid_blocks, ws_size); grid_blocks = -1; }
    }
    if (grid_blocks < 0) return;
    Params p{};
    p.x = (const float*)d_in[0]; p.g_mix = (const float*)d_in[1]; p.w_in = (const float*)d_in[2]; p.w_ab = (const float*)d_in[3];
    p.w_rb = (const float*)d_in[4]; p.w_out = (const float*)d_in[5]; p.g_ffn = (const float*)d_in[6]; p.w_gr = (const float*)d_in[7];
    p.b_gr = (const float*)d_in[8]; p.w_er = (const float*)d_in[9]; p.b_er = (const float*)d_in[10]; p.w_gate = (const float*)d_in[11];
    p.w_up = (const float*)d_in[12]; p.w_down = (const float*)d_in[13]; p.g_final = (const float*)d_in[14];
    p.out = (float*)d_out; p.ws = (char*)d_ws; p.ob = (char*)d_out;
    void* args[] = {&p};
    hipError_t e = hipLaunchCooperativeKernel((const void*)fwd_megakernel, dim3(grid_blocks), dim3(NTHR), args, LDS_BYTES, stream);
    if (e != hipSuccess) fprintf(stderr, "cooperative launch failed: %s (grid %d)\n", hipGetErrorString(e), grid_blocks);
}
```

```cpp
#include <hip/hip_runtime.h>
#include <hip/hip_cooperative_groups.h>
#include <stdint.h>
#include <cstdio>
namespace cg = cooperative_groups;

namespace pg8 {
#define PG8_LAS __attribute__((address_space(3)))
typedef unsigned short bf16_t;
typedef short bf16x8 __attribute__((ext_vector_type(8)));
typedef float f32x4 __attribute__((ext_vector_type(4)));
typedef unsigned u32x4 __attribute__((ext_vector_type(4)));
constexpr int BM = 256, BK = 64, HALF = 128, HTB = HALF * BK * 2  , STAGE_BYTES = 8 * HTB, NXCD = 8, WGM = 8;

__host__ __device__ __forceinline__ int lds_byte(int r, int c) { const int st = (r >> 4) * 2 + (c >> 5), rr = r & 15, cc = c & 31, ob = rr * 64 + cc * 2; return st * 1024 + (ob ^ (((ob >> 9) & 1) << 5)); }
__host__ __device__ __forceinline__ void stage_rc(int b, int& R, int& C) { const int st = b / 1024, sb = b % 1024, swz = sb ^ (((sb >> 9) & 1) << 5); R = (st >> 1) * 16 + swz / 64; C = (st & 1) * 32 + (swz % 64) / 2; }
__host__ __device__ __forceinline__ int perm32(int rho) { const int n = rho >> 4, i = rho & 15; return 8 * (i >> 2) + 4 * n + (i & 3); }

__device__ __forceinline__ int pg8_fresh_tid() { int t = threadIdx.x; asm volatile("" : "+v"(t)); return t; }
struct Unit { int pm, pn; };
struct Gemm { const bf16_t* A; const bf16_t* Bt; int M, N, K; };

struct StaticOrder {
    int nM, nN, nwg, G, c;
    __host__ __device__ void init(int M, int N, int G_, int c_) { nM = M / BM; nN = N / BM; nwg = nM * nN; G = G_; c = c_; }
    __host__ __device__ bool next(int i, Unit& u) const {
        const long L = (long)i * G + c; if (L >= nwg) return false;
        int wgid = (int)L; { const int q = nwg / NXCD, r = nwg % NXCD, xcd = wgid % NXCD, off = wgid / NXCD; wgid = (xcd < r ? xcd * (q + 1) : r * (q + 1) + (xcd - r) * q) + off; }
        const int nig = WGM * nN, gid = wgid / nig, fm = gid * WGM, gsz = (nM - fm) < WGM ? (nM - fm) : WGM;
        u.pm = fm + ((wgid % nig) % gsz); u.pn = (wgid % nig) / gsz; return true;
    }
    __device__ __forceinline__ void a_ready(const Unit&) const {}
    __device__ __forceinline__ void done(const Unit&) const {}
};

__device__ __forceinline__ unsigned cvt_pk_bf16(float lo, float hi) { unsigned r; asm volatile("v_cvt_pk_bf16_f32 %0, %1, %2" : "=v"(r) : "v"(lo), "v"(hi)); return r; }

template <class Epi, class Sched, bool ALIGN_EPI = false, bool SP2 = false>
__device__ __forceinline__ void gemm_phase(PG8_LAS unsigned char* lds, const Gemm g, const Sched& S, const Epi& E) {
    const int tid = pg8_fresh_tid(), wid = __builtin_amdgcn_readfirstlane(tid >> 6), lane = tid & 63, wr = wid >> 2, wc = wid & 3, fr = lane & 15, fq = lane >> 4;
    const int K = g.K, nt = K / BK;
    unsigned voffA[2], voffB[2];
#pragma unroll
    for (int i = 0; i < 2; ++i) { int R, C; stage_rc(tid * 16 + i * 8192, R, C); const int Rb = Epi::PERM ? ((R & ~31) + perm32(R & 31)) : R;
        voffA[i] = (unsigned)(R * K + C) * 2u; voffB[i] = (unsigned)(Rb * K + C) * 2u; }
    const size_t kstep = (size_t)(BK * 2);
    const size_t hstep = (size_t)HALF * K * 2;
    const size_t tstep = 2 * hstep;
    const unsigned ldsw = (unsigned)wid * 1024u;
    const int aoff = lds_byte(wr * 64 + fr, fq * 8), boff = lds_byte(wc * 32 + fr, fq * 8);
#define PG8_SA(b, h) (((b) * 2 + (h)) * HTB)
#define PG8_SB(b, h) ((4 + (b) * 2 + (h)) * HTB)
#define PG8_STAGE(bufoff, gbase, voff) do { _Pragma("unroll") for (int _i = 0; _i < 2; ++_i) \
        __builtin_amdgcn_global_load_lds((const unsigned*)((const char*)(gbase) + (voff)[_i]), (PG8_LAS unsigned*)(lds + (bufoff) + ldsw + _i * 8192), 16, 0, 0); } while (0)
#define PG8_LDA(dst, b, h) do { _Pragma("unroll") for (int m = 0; m < 4; ++m) _Pragma("unroll") for (int k = 0; k < 2; ++k) dst[m][k] = *(const PG8_LAS bf16x8*)(lds + PG8_SA(b, h) + aoff + m * 2048 + k * 1024); } while (0)
#define PG8_LDB(dst, b, h) do { _Pragma("unroll") for (int n = 0; n < 2; ++n) _Pragma("unroll") for (int k = 0; k < 2; ++k) dst[n][k] = *(const PG8_LAS bf16x8*)(lds + PG8_SB(b, h) + boff + n * 2048 + k * 1024); } while (0)
#define PG8_MMA(ai, bj, At, Bt) do { __builtin_amdgcn_s_setprio(1); _Pragma("unroll") for (int m = 0; m < 4; ++m) _Pragma("unroll") for (int n = 0; n < 2; ++n) _Pragma("unroll") for (int k = 0; k < 2; ++k) \
        acc[ai][bj][m][n] = __builtin_amdgcn_mfma_f32_16x16x32_bf16(Bt[n][k], At[m][k], acc[ai][bj][m][n], 0, 0, 0); __builtin_amdgcn_s_setprio(0); } while (0)
#define PG8_WAIT_V(n) asm volatile("s_waitcnt vmcnt(" #n ")" ::: "memory")
#define PG8_WAIT_L(n) asm volatile("s_waitcnt lgkmcnt(" #n ")" ::: "memory")
#define PG8_BAR __builtin_amdgcn_s_barrier()
#define PG8_SCHED __builtin_amdgcn_sched_barrier(0)
    Unit cur, nxt; int ui = 0;
    if (!S.next(0, cur)) return;
    f32x4 acc[2][2][4][2];
#pragma unroll
    for (int a = 0; a < 2; ++a)
#pragma unroll
        for (int b = 0; b < 2; ++b)
#pragma unroll
            for (int m = 0; m < 4; ++m)
#pragma unroll
                for (int n = 0; n < 2; ++n) acc[a][b][m][n] = (f32x4){0.f, 0.f, 0.f, 0.f};
    bf16x8 At[4][2], B0[2][2], B1[2][2];
    const char* cA = (const char*)g.A + (size_t)cur.pm * tstep; const char* cB = (const char*)g.Bt + (size_t)cur.pn * tstep;
    S.a_ready(cur);
    if constexpr (SP2) {
        PG8_STAGE(PG8_SB(0, 0), cB, voffB); PG8_STAGE(PG8_SB(0, 1), cB + hstep, voffB); PG8_STAGE(PG8_SA(0, 0), cA, voffA); PG8_STAGE(PG8_SA(0, 1), cA + hstep, voffA);
        if (wr == 1) PG8_BAR;
        PG8_WAIT_V(2); PG8_BAR;
        PG8_STAGE(PG8_SB(1, 0), cB + kstep, voffB); PG8_STAGE(PG8_SA(1, 0), cA + kstep, voffA); PG8_STAGE(PG8_SB(1, 1), cB + hstep + kstep, voffB);
        PG8_WAIT_V(6); PG8_BAR;
    } else {
        PG8_STAGE(PG8_SB(0, 0), cB, voffB); PG8_STAGE(PG8_SA(0, 0), cA, voffA); PG8_STAGE(PG8_SB(0, 1), cB + hstep, voffB); PG8_STAGE(PG8_SA(0, 1), cA + hstep, voffA);
        if (wr == 1) PG8_BAR;
        PG8_WAIT_V(4); PG8_BAR;
        PG8_STAGE(PG8_SB(1, 0), cB + kstep, voffB); PG8_STAGE(PG8_SA(1, 0), cA + kstep, voffA); PG8_STAGE(PG8_SB(1, 1), cB + hstep + kstep, voffB);
        PG8_WAIT_V(6); PG8_BAR;
    }
    for (;;) {
        const bool has_next = S.next(ui + 1, nxt);
        const char* nA = has_next ? (const char*)g.A + (size_t)nxt.pm * tstep : cA; const char* nB = has_next ? (const char*)g.Bt + (size_t)nxt.pn * tstep : cB;
        for (int t = 0; t < nt; t += 2) {
            const bool last = (t == nt - 2);
            const char* a1 = cA + (size_t)(t + 1) * kstep;
            const char* a2 = last ? nA : cA + (size_t)(t + 2) * kstep; const char* b2 = last ? nB : cB + (size_t)(t + 2) * kstep;
            const char* a3 = a2 + kstep; const char* b3 = b2 + kstep;
            if (last && has_next) S.a_ready(nxt);
            if constexpr (SP2) {
            PG8_LDB(B0, 0, 0); PG8_LDB(B1, 0, 1); PG8_SCHED; PG8_LDA(At, 0, 0); PG8_STAGE(PG8_SA(1, 1), a1 + hstep, voffA);
            PG8_WAIT_V(8); PG8_WAIT_L(0); PG8_BAR; PG8_MMA(0, 0, At, B0); PG8_MMA(0, 1, At, B1); PG8_BAR; PG8_SCHED;
            PG8_LDA(At, 0, 1); PG8_STAGE(PG8_SB(0, 0), b2, voffB); PG8_STAGE(PG8_SB(0, 1), b2 + hstep, voffB); PG8_STAGE(PG8_SA(0, 0), a2, voffA);
            PG8_WAIT_V(8); PG8_WAIT_L(0); PG8_BAR; PG8_MMA(1, 0, At, B0); PG8_MMA(1, 1, At, B1); PG8_BAR; PG8_SCHED;
            PG8_LDB(B0, 1, 0); PG8_LDB(B1, 1, 1); PG8_SCHED; PG8_LDA(At, 1, 0); PG8_STAGE(PG8_SA(0, 1), a2 + hstep, voffA);
            PG8_WAIT_V(8); PG8_WAIT_L(0); PG8_BAR; PG8_MMA(0, 0, At, B0); PG8_MMA(0, 1, At, B1); PG8_BAR; PG8_SCHED;
            PG8_LDA(At, 1, 1); PG8_STAGE(PG8_SB(1, 0), b3, voffB); PG8_STAGE(PG8_SB(1, 1), b3 + hstep, voffB); PG8_STAGE(PG8_SA(1, 0), a3, voffA);
            PG8_WAIT_V(8); PG8_WAIT_L(0); PG8_BAR; PG8_MMA(1, 0, At, B0); PG8_MMA(1, 1, At, B1); PG8_BAR; PG8_SCHED;
            } else {
            PG8_LDB(B0, 0, 0); PG8_SCHED; PG8_LDA(At, 0, 0); PG8_STAGE(PG8_SA(1, 1), a1 + hstep, voffA);
            PG8_WAIT_L(8); PG8_BAR; PG8_WAIT_L(0); PG8_MMA(0, 0, At, B0); PG8_BAR; PG8_SCHED;
            PG8_LDB(B1, 0, 1); PG8_STAGE(PG8_SB(0, 0), b2, voffB);
            PG8_BAR; PG8_WAIT_L(0); PG8_MMA(0, 1, At, B1); PG8_BAR;
            PG8_LDA(At, 0, 1); PG8_STAGE(PG8_SA(0, 0), a2, voffA);
            PG8_BAR; PG8_WAIT_L(0); PG8_MMA(1, 0, At, B0); PG8_BAR; PG8_SCHED;
            PG8_STAGE(PG8_SB(0, 1), b2 + hstep, voffB);
            PG8_WAIT_V(6); PG8_BAR; PG8_MMA(1, 1, At, B1); PG8_BAR;
            PG8_LDB(B0, 1, 0); PG8_SCHED; PG8_LDA(At, 1, 0); PG8_STAGE(PG8_SA(0, 1), a2 + hstep, voffA);
            PG8_WAIT_L(8); PG8_BAR; PG8_WAIT_L(0); PG8_MMA(0, 0, At, B0); PG8_BAR; PG8_SCHED;
            PG8_LDB(B1, 1, 1); PG8_STAGE(PG8_SB(1, 0), b3, voffB);
            PG8_BAR; PG8_WAIT_L(0); PG8_MMA(0, 1, At, B1); PG8_BAR;
            PG8_LDA(At, 1, 1); PG8_STAGE(PG8_SA(1, 0), a3, voffA);
            PG8_BAR; PG8_WAIT_L(0); PG8_MMA(1, 0, At, B0); PG8_BAR; PG8_SCHED;
            PG8_STAGE(PG8_SB(1, 1), b3 + hstep, voffB);
            PG8_WAIT_V(6); PG8_BAR; PG8_MMA(1, 1, At, B1); PG8_BAR;
            }
        }
        if constexpr (ALIGN_EPI) { if (wr == 0) PG8_BAR; }
        if constexpr (!Epi::AFTER_DRAIN) { E(acc, cur, wr, wc, fr, fq); S.done(cur); }
        if (!has_next) break;
#pragma unroll
        for (int a = 0; a < 2; ++a)
#pragma unroll
            for (int b = 0; b < 2; ++b)
#pragma unroll
                for (int m = 0; m < 4; ++m)
#pragma unroll
                    for (int n = 0; n < 2; ++n) acc[a][b][m][n] = (f32x4){0.f, 0.f, 0.f, 0.f};
        cur = nxt; cA = nA; cB = nB; ++ui;
        if constexpr (ALIGN_EPI) { if (wr == 1) PG8_BAR; }
    }
    PG8_WAIT_V(0);
    if constexpr (!ALIGN_EPI) { if (wr == 0) PG8_BAR; }
    PG8_BAR;
    if constexpr (Epi::AFTER_DRAIN) { E.fused(acc, cur, wr, wc, fr, fq, lds, wid, lane); S.done(cur); }
#undef PG8_SA
#undef PG8_SB
#undef PG8_STAGE
#undef PG8_LDA
#undef PG8_LDB
#undef PG8_MMA
#undef PG8_WAIT_V
#undef PG8_WAIT_L
#undef PG8_BAR
#undef PG8_SCHED
}
}


using pg8::bf16_t;
using pg8::bf16x8;
using pg8::f32x4;
using pg8::u32x4;
#define LAS __attribute__((address_space(3)))
#define GAS __attribute__((address_space(1)))
typedef unsigned v4u __attribute__((ext_vector_type(4)));

#define NTOK 16384
#define SEQ 4096
#define DM 1024
#define NTHR 512
#define LDS_BYTES 147456
constexpr size_t MiB = (size_t)1 << 20;
constexpr size_t WS_CTL = 0, WS_WINT = 1, WS_PAT = 20, WS_PRT = 21, WS_WOT = 23;
constexpr size_t WS_KA = 26, WS_VA = 74, WS_QR = 122, WS_KR = 138, WS_VR = 154, WS_QA = 186, WS_GSW = 234, WS_GA = 266, WS_END = 298;
constexpr size_t WS_OATTN = 1;
constexpr size_t WS_KVF = 26, WS_ST = 90, WS_ORET = 26;
constexpr size_t WS_X1 = 122;
constexpr size_t WS_MERGED = 186;
constexpr size_t WS_ROUTE = 17;
constexpr size_t WS_WGU = 26, WS_WD = 90;
constexpr size_t WS_XS = 186;
constexpr size_t WS_Y01 = 186;
constexpr size_t R_WGCNT = 0, R_TOKE = 65536, R_TOKRANK = 196608, R_TOKW = 327680, R_RSTD = 458752, R_SLOTTOK = 524288, R_SLOTW = 720896;
constexpr int LDS_MOE = 131072;

__device__ __forceinline__ bf16_t f2bf(float f) { unsigned u = __float_as_uint(f); return (bf16_t)((u + 0x7fffu + ((u >> 16) & 1u)) >> 16); }
__device__ __forceinline__ unsigned pk2(float lo, float hi) { return (unsigned)f2bf(lo) | ((unsigned)f2bf(hi) << 16); }
__device__ __forceinline__ float bf2f(bf16_t h) { return __uint_as_float(((unsigned)h) << 16); }
__device__ __forceinline__ float bflo(unsigned w) { return __uint_as_float(w << 16); }
__device__ __forceinline__ float bfhi(unsigned w) { return __uint_as_float(w & 0xffff0000u); }
__device__ __forceinline__ float wave_sum(float v) {
#pragma unroll
    for (int o = 32; o >= 1; o >>= 1) v += __shfl_xor(v, o);
    return v;
}
__device__ __forceinline__ float sigmoidf_fast(float g) { return __builtin_amdgcn_rcpf(1.0f + __expf(-g)); }
#define LDS_WAIT() asm volatile("s_waitcnt lgkmcnt(0)" ::: "memory")
__device__ __forceinline__ int fresh_tid() { int t = threadIdx.x; asm volatile("" : "+v"(t)); return t; }

struct Params {
    const float *x, *g_mix, *w_in, *w_ab, *w_rb, *w_out, *g_ffn, *w_gr, *b_gr, *w_er, *b_er, *w_gate, *w_up, *w_down, *g_final;
    float* out; char* ws; char* ob;
};

__device__ __forceinline__ float block_sum512(float v, float* red) {
    v = wave_sum(v);
    __syncthreads();
    if ((threadIdx.x & 63) == 0) red[threadIdx.x >> 6] = v;
    __syncthreads();
    float s = 0.f;
#pragma unroll
    for (int i = 0; i < 8; ++i) s += red[i];
    return s;
}

template <bool GU>
__device__ __forceinline__ void p0_transpose_item(const float* W, int K, int N, bf16_t* WT, int row_off, LAS float* scr, int item, int lane) {
    const int nblk = N / 32, kb = item / nblk, nb = item % nblk, k0 = 64 * kb, n0 = 32 * nb;
#pragma unroll 8
    for (int i = 0; i < 32; ++i) { const int kk = 2 * i + (lane >> 5); scr[kk * 33 + (lane & 31)] = W[(size_t)(k0 + kk) * N + n0 + (lane & 31)]; }
    LDS_WAIT(); asm volatile("" ::: "memory");
    const int c = lane & 7;
#pragma unroll
    for (int j = 0; j < 4; ++j) { const int n = (lane >> 3) + 8 * j; const LAS float* s = scr + (8 * c) * 33 + n;
        v4u o; o.x = pk2(s[0 * 33], s[1 * 33]); o.y = pk2(s[2 * 33], s[3 * 33]); o.z = pk2(s[4 * 33], s[5 * 33]); o.w = pk2(s[6 * 33], s[7 * 33]);
        const int drow = GU ? ((((n0 + n) >> 2) << 3) + ((n0 + n) & 3) + row_off) : (row_off + n0 + n);
        *(GAS v4u*)(WT + (size_t)drow * K + k0 + 8 * c) = o; }
    LDS_WAIT(); asm volatile("" ::: "memory");
}
__device__ __forceinline__ void ph_transpose_all(const float* W, int K, int N, int nmat, bf16_t* WT, LAS unsigned char* lds) {
    const int tid_ = fresh_tid(); const int wave = tid_ >> 6, lane = tid_ & 63;
    LAS float* scr = (LAS float*)(lds + wave * 16384);
    const int gw = blockIdx.x * 8 + wave, NGW = gridDim.x * 8;
    const int per = (K / 64) * (N / 32), total = per * nmat;
    for (int it = gw; it < total; it += NGW) {
        const int mi = it / per, r = it % per;
        p0_transpose_item<false>(W + (size_t)mi * K * N, K, N, WT + (size_t)mi * K * N, 0, scr, r, lane);
    }
}
__device__ __forceinline__ void ph_transpose_gu(const float* Wg, const float* Wu, bf16_t* WT, LAS unsigned char* lds) {
    const int tid_ = fresh_tid(); const int wave = tid_ >> 6, lane = tid_ & 63;
    LAS float* scr = (LAS float*)(lds + wave * 16384);
    const int gw = blockIdx.x * 8 + wave, NGW = gridDim.x * 8;
    const int per = (1024 / 64) * (512 / 32), total = per * 64;
    for (int it = gw; it < total; it += NGW) {
        const int mi = it / per, r = it % per, e = mi >> 1, up = mi & 1;
        p0_transpose_item<true>((up ? Wu : Wg) + (size_t)e * 1024 * 512, 1024, 512, WT + (size_t)e * 1024 * 1024, up * 4, scr, r, lane);
    }
}

__device__ __forceinline__ void ph_rmsnorm_bf16(const float* __restrict__ x, const float* __restrict__ g, bf16_t* __restrict__ out) {
    const int tid_ = fresh_tid(); const int lane = tid_ & 63, gw = blockIdx.x * 8 + (tid_ >> 6), ngw = gridDim.x * 8;
    for (int row = gw; row < NTOK; row += ngw) {
        float4 v[4]; float ss = 0.f;
#pragma unroll
        for (int j = 0; j < 4; ++j) { v[j] = ((const float4*)(x + (size_t)row * DM))[lane + 64 * j]; ss += v[j].x * v[j].x + v[j].y * v[j].y + v[j].z * v[j].z + v[j].w * v[j].w; }
        ss = wave_sum(ss);
        const float r = rsqrtf(ss * (1.0f / DM) + 1e-6f);
#pragma unroll
        for (int j = 0; j < 4; ++j) {
            const float4 gg = ((const float4*)g)[lane + 64 * j];
            uint2 o; o.x = pk2(v[j].x * r * gg.x, v[j].y * r * gg.y); o.y = pk2(v[j].z * r * gg.z, v[j].w * r * gg.w);
            ((uint2*)(out + (size_t)row * DM))[lane + 64 * j] = o;
        }
    }
}

struct EpiProj {
    static constexpr bool PERM = true, AFTER_DRAIN = false;
    char* ws; char* ob;
    __device__ __forceinline__ void operator()(const f32x4 (&acc)[2][2][4][2], const pg8::Unit& u, int wr, int wc, int fr, int fq) const {
        const int pn = u.pn;
        size_t off; int w, t0;
        if (pn < 6) { off = WS_QA * MiB; w = 1536; t0 = 0; }
        else if (pn < 12) { off = WS_KA * MiB; w = 1536; t0 = 6; }
        else if (pn < 18) { off = WS_VA * MiB; w = 1536; t0 = 12; }
        else if (pn < 20) { off = WS_QR * MiB; w = 512; t0 = 18; }
        else if (pn < 22) { off = WS_KR * MiB; w = 512; t0 = 20; }
        else if (pn < 26) { off = WS_VR * MiB; w = 1024; t0 = 22; }
        else if (pn < 30) { off = WS_GSW * MiB; w = 1024; t0 = 26; }
        else if (pn < 34) { off = WS_GA * MiB; w = 1024; t0 = 30; }
        else { off = 32 * MiB; w = 1024; t0 = 34; }
        bf16_t* base = (bf16_t*)((pn >= 34 ? ob : ws) + off);
        const float sc = (pn < 6) ? 0.18033688011112042f : 1.0f;
        const int row0 = u.pm * 256 + wr * 64 + fr, col0 = (pn - t0) * 256 + wc * 32 + 8 * fq;
#pragma unroll
        for (int ai = 0; ai < 2; ++ai)
#pragma unroll
            for (int m = 0; m < 4; ++m) {
                bf16_t* rowp = base + (size_t)(row0 + ai * 128 + m * 16) * w + col0;
#pragma unroll
                for (int bj = 0; bj < 2; ++bj) {
                    const f32x4 v0 = acc[ai][bj][m][0] * sc, v1 = acc[ai][bj][m][1] * sc;
                    u32x4 o; o.x = pk2(v0[0], v0[1]); o.y = pk2(v0[2], v0[3]); o.z = pk2(v1[0], v1[1]); o.w = pk2(v1[2], v1[3]);
                    *(u32x4*)(rowp + bj * 128) = o;
                }
            }
    }
};
struct EpiGate {
    static constexpr bool PERM = true, AFTER_DRAIN = false;
    const bf16_t* gate; bf16_t* merged; int accumulate;
    __device__ __forceinline__ void operator()(const f32x4 (&acc)[2][2][4][2], const pg8::Unit& u, int wr, int wc, int fr, int fq) const {
        const int row0 = u.pm * 256 + wr * 64 + fr, col0 = u.pn * 256 + wc * 32 + 8 * fq;
#pragma unroll
        for (int ai = 0; ai < 2; ++ai)
#pragma unroll
            for (int m = 0; m < 4; ++m)
#pragma unroll
                for (int bj = 0; bj < 2; ++bj) {
                    const size_t idx = (size_t)(row0 + ai * 128 + m * 16) * 1024 + col0 + bj * 128;
                    const u32x4 g = *(const u32x4*)(gate + idx);
                    const f32x4 v0 = acc[ai][bj][m][0], v1 = acc[ai][bj][m][1];
                    float o[8];
                    o[0] = v0[0] * sigmoidf_fast(bflo(g.x)); o[1] = v0[1] * sigmoidf_fast(bfhi(g.x));
                    o[2] = v0[2] * sigmoidf_fast(bflo(g.y)); o[3] = v0[3] * sigmoidf_fast(bfhi(g.y));
                    o[4] = v1[0] * sigmoidf_fast(bflo(g.z)); o[5] = v1[1] * sigmoidf_fast(bfhi(g.z));
                    o[6] = v1[2] * sigmoidf_fast(bflo(g.w)); o[7] = v1[3] * sigmoidf_fast(bfhi(g.w));
                    if (accumulate) {
                        const u32x4 p = *(const u32x4*)(merged + idx);
                        o[0] += bflo(p.x); o[1] += bfhi(p.x); o[2] += bflo(p.y); o[3] += bfhi(p.y);
                        o[4] += bflo(p.z); o[5] += bfhi(p.z); o[6] += bflo(p.w); o[7] += bfhi(p.w);
                    }
                    u32x4 w; w.x = pk2(o[0], o[1]); w.y = pk2(o[2], o[3]); w.z = pk2(o[4], o[5]); w.w = pk2(o[6], o[7]);
                    *(u32x4*)(merged + idx) = w;
                }
    }
};
struct EpiResid {
    static constexpr bool PERM = true, AFTER_DRAIN = false;
    const float* x; float* x1;
    __device__ __forceinline__ void operator()(const f32x4 (&acc)[2][2][4][2], const pg8::Unit& u, int wr, int wc, int fr, int fq) const {
        const int row0 = u.pm * 256 + wr * 64 + fr, col0 = u.pn * 256 + wc * 32 + 8 * fq;
#pragma unroll
        for (int ai = 0; ai < 2; ++ai)
#pragma unroll
            for (int m = 0; m < 4; ++m)
#pragma unroll
                for (int bj = 0; bj < 2; ++bj) {
                    const size_t idx = (size_t)(row0 + ai * 128 + m * 16) * 1024 + col0 + bj * 128;
                    const f32x4 a = *(const f32x4*)(x + idx), b = *(const f32x4*)(x + idx + 4);
                    *(f32x4*)(x1 + idx) = a + acc[ai][bj][m][0];
                    *(f32x4*)(x1 + idx + 4) = b + acc[ai][bj][m][1];
                }
    }
};


typedef short v4i16_t __attribute__((ext_vector_type(4)));
__device__ __forceinline__ unsigned cvtpk_bf16(float lo, float hi) {
    typedef float f32x2_t __attribute__((ext_vector_type(2))); typedef __bf16 bf16x2_t __attribute__((ext_vector_type(2)));
    f32x2_t v = {lo, hi}; bf16x2_t b = __builtin_convertvector(v, bf16x2_t); return __builtin_bit_cast(unsigned, b);
}
template <int NT>
__device__ __forceinline__ void attn_group(const bf16_t* __restrict__ qa, const bf16_t* __restrict__ ka, const bf16_t* __restrict__ va,
                                           int b, int h, int grp, int d, int rho, int L, const int* cq0, int cqstep, int ck_start, int nchunks, float bslope,
                                           f32x4* o  , float* m  , float* l  , LAS unsigned char* vbuf, int lane) {
    const int c = lane & 15, g = lane >> 4;
    const size_t hoff = (size_t)grp * 512 + h * 64;
    bf16x8 qf[NT][2]; int jl[NT], jmax[NT];
#pragma unroll
    for (int t = 0; t < NT; ++t) {
        const int cq = cq0[t] + cqstep * c;
        const bf16_t* qp = qa + (size_t)(b * SEQ + cq * d + rho) * 1536 + hoff + 8 * g;
        qf[t][0] = *(const bf16x8*)qp; qf[t][1] = *(const bf16x8*)(qp + 32);
        jl[t] = cq - ck_start - 4 * g; jmax[t] = cq < 128 ? cq : 128;
    }
    const int tq = c >> 2, tp = c & 3;
    const int vr0 = 4 * g + tq, vr1 = 16 + 4 * g + tq;
    const int vx0 = ((vr0 >> 1) & 3) << 1, vx1 = ((vr1 >> 1) & 3) << 1;
    int voff0[4], voff1[4];
#pragma unroll
    for (int n = 0; n < 4; ++n) {
        voff0[n] = vr0 * 128 + (((2 * n + (tp >> 1)) ^ vx0) << 4) + 8 * (tp & 1);
        voff1[n] = vr1 * 128 + (((2 * n + (tp >> 1)) ^ vx1) << 4) + 8 * (tp & 1);
    }
    const int dr = lane >> 3, dcp = lane & 7;
    auto issue_v = [&](int chunk, int buf) {
#pragma unroll
        for (int ii = 0; ii < 4; ++ii) {
            const int r = 8 * ii + dr;
            int ck = ck_start + 32 * chunk + r; ck = ck < 0 ? 0 : (ck > L - 1 ? L - 1 : ck);
            const int ch = dcp ^ (((r >> 1) & 3) << 1);
            const bf16_t* src = va + (size_t)(b * SEQ + ck * d + rho) * 1536 + hoff + ch * 8;
            __builtin_amdgcn_global_load_lds((const unsigned*)src, (LAS unsigned*)(vbuf + buf * 4096 + ii * 1024), 16, 0, 0);
        }
    };
    auto load_k = [&](int chunk, bf16x8* kf) {
#pragma unroll
        for (int kt = 0; kt < 2; ++kt) {
            int ck = ck_start + 32 * chunk + 16 * kt + c; ck = ck < 0 ? 0 : (ck > L - 1 ? L - 1 : ck);
            const bf16_t* kp = ka + (size_t)(b * SEQ + ck * d + rho) * 1536 + hoff + 8 * g;
            kf[2 * kt] = *(const bf16x8*)kp; kf[2 * kt + 1] = *(const bf16x8*)(kp + 32);
        }
    };
    bf16x8 kn[4];
    load_k(0, kn); issue_v(0, 0);
    for (int chunk = 0; chunk < nchunks; ++chunk) {
        asm volatile("s_waitcnt vmcnt(0)" ::: "memory");
        bf16x8 kc[4];
#pragma unroll
        for (int i = 0; i < 4; ++i) kc[i] = kn[i];
        if (chunk + 1 < nchunks) { load_k(chunk + 1, kn); issue_v(chunk + 1, (chunk + 1) & 1); }
        LAS unsigned char* vb = vbuf + (chunk & 1) * 4096;
        bf16x8 vf[4];
#pragma unroll
        for (int n = 0; n < 4; ++n) {
            const v4i16_t lo = __builtin_amdgcn_ds_read_tr16_b64_v4i16((LAS v4i16_t*)(vb + voff0[n]));
            const v4i16_t hi = __builtin_amdgcn_ds_read_tr16_b64_v4i16((LAS v4i16_t*)(vb + voff1[n]));
            vf[n] = (bf16x8){lo[0], lo[1], lo[2], lo[3], hi[0], hi[1], hi[2], hi[3]};
        }
#pragma unroll
        for (int t = 0; t < NT; ++t) {
            f32x4 sA = {0.f, 0.f, 0.f, 0.f}, sB = {0.f, 0.f, 0.f, 0.f};
            sA = __builtin_amdgcn_mfma_f32_16x16x32_bf16(kc[0], qf[t][0], sA, 0, 0, 0);
            sA = __builtin_amdgcn_mfma_f32_16x16x32_bf16(kc[1], qf[t][1], sA, 0, 0, 0);
            sB = __builtin_amdgcn_mfma_f32_16x16x32_bf16(kc[2], qf[t][0], sB, 0, 0, 0);
            sB = __builtin_amdgcn_mfma_f32_16x16x32_bf16(kc[3], qf[t][1], sB, 0, 0, 0);
            const int jc = jl[t] - 32 * chunk;
            float s[8]; float cm = -1e30f;
#pragma unroll
            for (int e = 0; e < 8; ++e) {
                const int j = jc - ((e & 3) + 16 * (e >> 2));
                const float v = ((e < 4) ? sA[e & 3] : sB[e & 3]) - bslope * (float)j;
                s[e] = ((unsigned)j <= (unsigned)jmax[t]) ? v : -1e30f;
                cm = fmaxf(cm, s[e]);
            }
            cm = fmaxf(cm, __shfl_xor(cm, 16)); cm = fmaxf(cm, __shfl_xor(cm, 32));
            const float mn = fmaxf(m[t], cm);
            const float alpha = __builtin_amdgcn_exp2f(m[t] - mn);
            m[t] = mn;
            float p[8]; float ps = 0.f;
#pragma unroll
            for (int e = 0; e < 8; ++e) { p[e] = (s[e] > -1e29f) ? __builtin_amdgcn_exp2f(s[e] - mn) : 0.f; ps += p[e]; }
            l[t] = l[t] * alpha + ps;
            u32x4 pw; pw.x = cvtpk_bf16(p[0], p[1]); pw.y = cvtpk_bf16(p[2], p[3]); pw.z = cvtpk_bf16(p[4], p[5]); pw.w = cvtpk_bf16(p[6], p[7]);
            const bf16x8 pf = __builtin_bit_cast(bf16x8, pw);
#pragma unroll
            for (int n = 0; n < 4; ++n) {
                f32x4 ov = o[t * 4 + n];
                ov = ov * alpha;
                o[t * 4 + n] = __builtin_amdgcn_mfma_f32_16x16x32_bf16(vf[n], pf, ov, 0, 0, 0);
            }
        }
    }
}
__device__ __forceinline__ void ph_attn(const bf16_t* __restrict__ qa, const bf16_t* __restrict__ ka, const bf16_t* __restrict__ va, bf16_t* __restrict__ oattn, LAS unsigned char* lds) {
    const int tid_ = fresh_tid(); const int lane = tid_ & 63, w = __builtin_amdgcn_readfirstlane(tid_ >> 6);
    LAS unsigned char* vbuf = lds + w * 8192;
    const float LOG2E = 1.4426950408889634f;
    for (int unit = blockIdx.x; unit < 512; unit += gridDim.x) {
        const int b = unit >> 7, h = unit & 7, t0 = ((unit >> 3) & 15) * 256;
        const float slope = exp2f(-(float)(h + 1)) * LOG2E;
        f32x4 o[8]; float m[2] = {-1e30f, -1e30f}, l[2] = {0.f, 0.f};
#pragma unroll
        for (int i = 0; i < 8; ++i) o[i] = (f32x4){0.f, 0.f, 0.f, 0.f};
        {
            const int cq0[2] = {t0 + w, t0 + w + 8};
            attn_group<2>(qa, ka, va, b, h, 0, 1, 0, 4096, cq0, 16, t0 + w - 128, 12, slope, o, m, l, vbuf, lane);
        }
        {
            const int rho = w & 3, cA = (t0 + w - rho) >> 2;
            const int cq0[2] = {cA, cA + 2};
            attn_group<2>(qa, ka, va, b, h, 1, 4, rho, 1024, cq0, 4, cA - 128, 6, slope * 4.0f, o, m, l, vbuf, lane);
        }
        {
            const int cq0[1] = {t0 >> 4};
            attn_group<1>(qa, ka, va, b, h, 2, 16, w, 256, cq0, 1, (t0 >> 4) - 128, 5, slope * 16.0f, o, m, l, vbuf, lane);
            attn_group<1>(qa, ka, va, b, h, 2, 16, w + 8, 256, cq0, 1, (t0 >> 4) - 128, 5, slope * 16.0f, o + 4, m + 1, l + 1, vbuf, lane);
        }
        const int c = lane & 15, g = lane >> 4;
#pragma unroll
        for (int t = 0; t < 2; ++t) {
            float lt = l[t]; lt += __shfl_xor(lt, 16); lt += __shfl_xor(lt, 32);
            const float inv = 1.0f / lt;
            const int tok = t0 + w + 8 * t + 16 * c;
            bf16_t* op = oattn + (size_t)(b * SEQ + tok) * 512 + h * 64 + 4 * g;
#pragma unroll
            for (int n = 0; n < 4; ++n) {
                const f32x4 v = o[t * 4 + n] * inv;
                uint2 pk; pk.x = pk2(v[0], v[1]); pk.y = pk2(v[2], v[3]);
                *(uint2*)(op + 16 * n) = pk;
            }
        }
    }
}


typedef unsigned u32x2 __attribute__((ext_vector_type(2)));
__device__ __forceinline__ int trx(int row) { return ((row & 3) | (((row >> 3) & 1) << 2)) << 1; }
template <int ROWB>
__device__ __forceinline__ void dma_tile128(const bf16_t* gsrc, size_t gstride, LAS unsigned char* dst, int wid, int lane) {
    constexpr int CPR = ROWB / 16, RPI = 64 / CPR, NI = 128 / RPI;
    for (int ii = wid; ii < NI; ii += 8) {
        const int row = ii * RPI + lane / CPR, cp = lane % CPR, ch = cp ^ trx(row);
        const bf16_t* src = gsrc + (size_t)row * gstride + ch * 8;
        __builtin_amdgcn_global_load_lds((const unsigned*)src, (LAS unsigned*)(dst + ii * 1024), 16, 0, 0);
    }
}
template <int ROWB>
__device__ __forceinline__ bf16x8 tr_frag(LAS unsigned char* img, int ks, int n, int lane) {
    const int g = lane >> 4, q = (lane & 15) >> 2, p = lane & 3;
    const int r0 = 32 * ks + 8 * g + q, r1 = r0 + 4;
    const v4i16_t lo = __builtin_amdgcn_ds_read_tr16_b64_v4i16((LAS v4i16_t*)(img + r0 * ROWB + (((2 * n + (p >> 1)) ^ trx(r0)) << 4) + 8 * (p & 1)));
    const v4i16_t hi = __builtin_amdgcn_ds_read_tr16_b64_v4i16((LAS v4i16_t*)(img + r1 * ROWB + (((2 * n + (p >> 1)) ^ trx(r1)) << 4) + 8 * (p & 1)));
    return (bf16x8){lo[0], lo[1], lo[2], lo[3], hi[0], hi[1], hi[2], hi[3]};
}
template <int ROWB>
__device__ __forceinline__ int tr_base(int n, int lane) {
    const int g = lane >> 4, q = (lane & 15) >> 2, p = lane & 3;
    return (8 * g + q) * ROWB + ((n ^ (q | ((g & 1) << 2))) << 5) + ((p >> 1) << 4) + 8 * (p & 1);
}
template <int ROWB>
__device__ __forceinline__ bf16x8 tr_frag_at(LAS unsigned char* img, int base, int ks) {
    const v4i16_t lo = __builtin_amdgcn_ds_read_tr16_b64_v4i16((LAS v4i16_t*)(img + base + ks * 32 * ROWB));
    const v4i16_t hi = __builtin_amdgcn_ds_read_tr16_b64_v4i16((LAS v4i16_t*)(img + base + ks * 32 * ROWB + 4 * ROWB));
    return (bf16x8){lo[0], lo[1], lo[2], lo[3], hi[0], hi[1], hi[2], hi[3]};
}
__device__ __forceinline__ float ret_log2gamma(int h) { return log2f(1.0f - exp2f(-5.0f - (float)h)); }

__device__ __forceinline__ void ph_ret_kv(const bf16_t* __restrict__ kr, const bf16_t* __restrict__ vr, float* __restrict__ KVf, LAS unsigned char* lds) {
    const int tid_ = fresh_tid(); const int lane = tid_ & 63, w = __builtin_amdgcn_readfirstlane(tid_ >> 6), c16 = lane & 15, g = lane >> 4;
    LAS unsigned char* kimg = lds; LAS unsigned char* vimg = lds + 32768;
    const float ksc = 0.08838834764831845f;
    for (int unit = blockIdx.x; unit < 512; unit += gridDim.x) {
        const int b = unit >> 7, h = (unit >> 5) & 3, c = unit & 31;
        const size_t tok0 = (size_t)b * SEQ + c * 128;
        const float lg = ret_log2gamma(h);
        __syncthreads();
        dma_tile128<256>(kr + tok0 * 512 + h * 128, 512, kimg, w, lane);
        dma_tile128<512>(vr + tok0 * 1024 + h * 256, 1024, vimg, w, lane);
        asm volatile("s_waitcnt vmcnt(0)" ::: "memory");
        __syncthreads();
        f32x4 acc[2][8];
#pragma unroll
        for (int i = 0; i < 2; ++i)
#pragma unroll
            for (int j = 0; j < 8; ++j) acc[i][j] = (f32x4){0.f, 0.f, 0.f, 0.f};
        int vb[2], kb[8];
#pragma unroll
        for (int dvt = 0; dvt < 2; ++dvt) vb[dvt] = tr_base<512>(2 * w + dvt, lane);
#pragma unroll
        for (int dkt = 0; dkt < 8; ++dkt) kb[dkt] = tr_base<256>(dkt, lane);
#pragma unroll 1
        for (int ks = 0; ks < 4; ++ks) {
            bf16x8 vf[2];
            float z[8];
#pragma unroll
            for (int j = 0; j < 8; ++j) z[j] = ksc * __builtin_amdgcn_exp2f(lg * (float)(127 - (32 * ks + 8 * g + j)));
#pragma unroll
            for (int dvt = 0; dvt < 2; ++dvt) {
                const bf16x8 raw = tr_frag_at<512>(vimg, vb[dvt], ks);
                unsigned pk[4];
#pragma unroll
                for (int j = 0; j < 8; j += 2) pk[j >> 1] = cvtpk_bf16(bf2f((bf16_t)raw[j]) * z[j], bf2f((bf16_t)raw[j + 1]) * z[j + 1]);
                vf[dvt] = __builtin_bit_cast(bf16x8, (u32x4){pk[0], pk[1], pk[2], pk[3]});
            }
#pragma unroll
            for (int dkt = 0; dkt < 8; ++dkt) {
                const bf16x8 kf = tr_frag_at<256>(kimg, kb[dkt], ks);
                acc[0][dkt] = __builtin_amdgcn_mfma_f32_16x16x32_bf16(vf[0], kf, acc[0][dkt], 0, 0, 0);
                acc[1][dkt] = __builtin_amdgcn_mfma_f32_16x16x32_bf16(vf[1], kf, acc[1][dkt], 0, 0, 0);
            }
        }
        float* outp = KVf + (size_t)unit * 32768;
#pragma unroll
        for (int dvt = 0; dvt < 2; ++dvt)
#pragma unroll
            for (int dkt = 0; dkt < 8; ++dkt)
#pragma unroll
                for (int reg = 0; reg < 4; ++reg) outp[(32 * w + 16 * dvt + 4 * g + reg) * 128 + 16 * dkt + c16] = acc[dvt][dkt][reg];
    }
}
__device__ __forceinline__ void ph_ret_scan(const float* __restrict__ KVf, bf16_t* __restrict__ ST) {
    for (int i = blockIdx.x * NTHR + fresh_tid(); i < 16 * 8192; i += gridDim.x * NTHR) {
        const int bh = i >> 13, e4 = i & 8191, h = bh & 3;
        const float g128 = exp2f(128.0f * ret_log2gamma(h));
        f32x4 st = {0.f, 0.f, 0.f, 0.f};
        const size_t base = (size_t)bh * 32 * 32768 + (size_t)e4 * 4;
#pragma unroll 8
        for (int c = 0; c < 32; ++c) {
            const f32x4 kv = *(const f32x4*)(KVf + base + (size_t)c * 32768);
            uint2 o; o.x = pk2(st[0], st[1]); o.y = pk2(st[2], st[3]);
            *(uint2*)(ST + base + (size_t)c * 32768) = o;
            st = st * g128 + kv;
        }
    }
}
__device__ __forceinline__ void ph_ret_out(const bf16_t* __restrict__ qr, const bf16_t* __restrict__ kr, const bf16_t* __restrict__ vr, const bf16_t* __restrict__ ST,
                                           const bf16_t* __restrict__ gsw, bf16_t* __restrict__ oret, LAS unsigned char* lds) {
    const int tid_ = fresh_tid(); const int lane = tid_ & 63, w = __builtin_amdgcn_readfirstlane(tid_ >> 6), c16 = lane & 15, g = lane >> 4;
    LAS unsigned char* vimg = lds; LAS unsigned char* pimg = lds + 65536; LAS float* red = (LAS float*)(lds + 98304);
    const float ksc = 0.08838834764831845f;
    for (int unit = blockIdx.x; unit < 512; unit += gridDim.x) {
        const int b = unit >> 7, h = (unit >> 5) & 3, c = unit & 31;
        const size_t tok0 = (size_t)b * SEQ + c * 128;
        const float lg = ret_log2gamma(h);
        __syncthreads();
        dma_tile128<512>(vr + tok0 * 1024 + h * 256, 1024, vimg, w, lane);
        {
            bf16x8 qf[4];
            const bf16_t* qp = qr + (tok0 + 16 * w + c16) * 512 + h * 128 + 8 * g;
#pragma unroll
            for (int ks = 0; ks < 4; ++ks) qf[ks] = *(const bf16x8*)(qp + 32 * ks);
            for (int kt = 0; kt < 8; ++kt) {
                u32x2 pw = {0u, 0u};
                if (kt <= w) {
                    const bf16_t* kp = kr + (tok0 + 16 * kt + c16) * 512 + h * 128 + 8 * g;
                    f32x4 s = {0.f, 0.f, 0.f, 0.f};
#pragma unroll
                    for (int ks = 0; ks < 4; ++ks) s = __builtin_amdgcn_mfma_f32_16x16x32_bf16(*(const bf16x8*)(kp + 32 * ks), qf[ks], s, 0, 0, 0);
                    float p[4];
#pragma unroll
                    for (int reg = 0; reg < 4; ++reg) {
                        const int dt = (16 * w + c16) - (16 * kt + 4 * g + reg);
                        p[reg] = dt >= 0 ? s[reg] * ksc * __builtin_amdgcn_exp2f(lg * (float)dt) : 0.f;
                    }
                    pw.x = cvtpk_bf16(p[0], p[1]); pw.y = cvtpk_bf16(p[2], p[3]);
                }
                *(LAS u32x2*)(pimg + (16 * w + c16) * 256 + (((2 * kt + (g >> 1)) ^ c16) << 4) + 8 * (g & 1)) = pw;
            }
        }
        asm volatile("s_waitcnt vmcnt(0)" ::: "memory");
        __syncthreads();
        f32x4 acc[2][8];
#pragma unroll
        for (int i = 0; i < 2; ++i)
#pragma unroll
            for (int j = 0; j < 8; ++j) acc[i][j] = (f32x4){0.f, 0.f, 0.f, 0.f};
        const bf16_t* stp = ST + (size_t)unit * 32768 + (size_t)(32 * w + c16) * 128 + 8 * g;
#pragma unroll
        for (int ks = 0; ks < 4; ++ks) {
            const bf16x8 sf0 = *(const bf16x8*)(stp + 32 * ks), sf1 = *(const bf16x8*)(stp + 16 * 128 + 32 * ks);
#pragma unroll
            for (int qt = 0; qt < 8; ++qt) {
                const bf16x8 qf2 = *(const bf16x8*)(qr + (tok0 + 16 * qt + c16) * 512 + h * 128 + 32 * ks + 8 * g);
                acc[0][qt] = __builtin_amdgcn_mfma_f32_16x16x32_bf16(sf0, qf2, acc[0][qt], 0, 0, 0);
                acc[1][qt] = __builtin_amdgcn_mfma_f32_16x16x32_bf16(sf1, qf2, acc[1][qt], 0, 0, 0);
            }
        }
#pragma unroll
        for (int qt = 0; qt < 8; ++qt) {
            const float xi = __builtin_amdgcn_exp2f(lg * (float)(16 * qt + c16 + 1));
            acc[0][qt] = acc[0][qt] * xi; acc[1][qt] = acc[1][qt] * xi;
        }
#pragma unroll
        for (int ks = 0; ks < 4; ++ks) {
            const bf16x8 vf0 = tr_frag_at<512>(vimg, tr_base<512>(2 * w, lane), ks), vf1 = tr_frag_at<512>(vimg, tr_base<512>(2 * w + 1, lane), ks);
#pragma unroll
            for (int qt = 2 * ks; qt < 8; ++qt) {
                const bf16x8 pf = *(LAS bf16x8*)(pimg + (16 * qt + c16) * 256 + (((4 * ks + g) ^ c16) << 4));
                acc[0][qt] = __builtin_amdgcn_mfma_f32_16x16x32_bf16(vf0, pf, acc[0][qt], 0, 0, 0);
                acc[1][qt] = __builtin_amdgcn_mfma_f32_16x16x32_bf16(vf1, pf, acc[1][qt], 0, 0, 0);
            }
        }
#pragma unroll
        for (int qt = 0; qt < 8; ++qt) {
            float s1 = 0.f, s2 = 0.f;
#pragma unroll
            for (int dvt = 0; dvt < 2; ++dvt)
#pragma unroll
                for (int reg = 0; reg < 4; ++reg) { const float v = acc[dvt][qt][reg]; s1 += v; s2 += v * v; }
            s1 += __shfl_xor(s1, 16); s1 += __shfl_xor(s1, 32);
            s2 += __shfl_xor(s2, 16); s2 += __shfl_xor(s2, 32);
            if (g == 0) { red[(w * 128 + 16 * qt + c16) * 2] = s1; red[(w * 128 + 16 * qt + c16) * 2 + 1] = s2; }
        }
        __syncthreads();
#pragma unroll
        for (int qt = 0; qt < 8; ++qt) {
            float t1 = 0.f, t2 = 0.f;
#pragma unroll
            for (int ww = 0; ww < 8; ++ww) { t1 += red[(ww * 128 + 16 * qt + c16) * 2]; t2 += red[(ww * 128 + 16 * qt + c16) * 2 + 1]; }
            const float mu = t1 * (1.0f / 256.0f);
            const float var = fmaxf(t2 * (1.0f / 256.0f) - mu * mu, 0.f);
            const float r = rsqrtf(var + 1e-6f);
            const size_t rowoff = (tok0 + 16 * qt + c16) * 1024 + h * 256 + 32 * w + 4 * g;
#pragma unroll
            for (int dvt = 0; dvt < 2; ++dvt) {
                const uint2 gs = *(const uint2*)(gsw + rowoff + 16 * dvt);
                const float g0 = bflo(gs.x), g1 = bfhi(gs.x), g2 = bflo(gs.y), g3 = bfhi(gs.y);
                const f32x4 v = acc[dvt][qt];
                uint2 o;
                o.x = pk2(g0 * sigmoidf_fast(g0) * (v[0] - mu) * r, g1 * sigmoidf_fast(g1) * (v[1] - mu) * r);
                o.y = pk2(g2 * sigmoidf_fast(g2) * (v[2] - mu) * r, g3 * sigmoidf_fast(g3) * (v[3] - mu) * r);
                *(uint2*)(oret + rowoff + 16 * dvt) = o;
            }
        }
    }
}

__device__ __forceinline__ void ph_route(const Params& p, const float* __restrict__ x1, char* route, LAS unsigned char* lds) {
    LAS float* logits = (LAS float*)lds;
    LAS int* sel_e = (LAS int*)(lds + 12288);
    LAS float* sel_w = (LAS float*)(lds + 12288 + 512);
    const int t = fresh_tid(), wid = t >> 6, lane = t & 63, c = lane & 15, q = lane >> 4;
    int* wgcnt = (int*)(route + R_WGCNT); int* tok_e = (int*)(route + R_TOKE); int* tok_rank = (int*)(route + R_TOKRANK);
    float* tok_w = (float*)(route + R_TOKW); float* rstd_o = (float*)(route + R_RSTD);
    for (int grp = blockIdx.x; grp < NTOK / 64; grp += gridDim.x) {
        const int tok0 = grp * 64;
        __syncthreads();
        if (wid < 4) {
            const int tok = tok0 + wid * 16 + c;
            f32x4 a0 = {0.f, 0.f, 0.f, 0.f}, a1 = a0, a2 = a0; float ssq = 0.f;
            const float* xr = x1 + (size_t)tok * DM + 4 * q;
            for (int k0 = 0; k0 < DM; k0 += 16) {
                const float4 xa = *(const float4*)(xr + k0);
                const float4 gg = *(const float4*)(p.g_ffn + k0 + 4 * q);
                ssq += xa.x * xa.x + xa.y * xa.y + xa.z * xa.z + xa.w * xa.w;
                const float av[4] = {xa.x * gg.x, xa.y * gg.y, xa.z * gg.z, xa.w * gg.w};
#pragma unroll
                for (int i = 0; i < 4; ++i) {
                    const int k = k0 + 4 * q + i;
                    const float b0 = p.w_er[k * 32 + c], b1 = p.w_er[k * 32 + 16 + c], b2 = (c < 4) ? p.w_gr[k * 4 + c] : 0.f;
                    a0 = __builtin_amdgcn_mfma_f32_16x16x4f32(av[i], b0, a0, 0, 0, 0);
                    a1 = __builtin_amdgcn_mfma_f32_16x16x4f32(av[i], b1, a1, 0, 0, 0);
                    a2 = __builtin_amdgcn_mfma_f32_16x16x4f32(av[i], b2, a2, 0, 0, 0);
                }
            }
            ssq += __shfl_xor(ssq, 16); ssq += __shfl_xor(ssq, 32);
            const float rstd = rsqrtf(ssq * (1.0f / DM) + 1e-6f);
            if (q == 0) rstd_o[tok] = rstd;
            const float be0 = p.b_er[c], be1 = p.b_er[16 + c], bg = (c < 4) ? p.b_gr[c] : 0.f;
#pragma unroll
            for (int reg = 0; reg < 4; ++reg) {
                const int r = 4 * q + reg;
                const float rs = __shfl(rstd, r);
                LAS float* lp = logits + (wid * 16 + r) * 48;
                lp[c] = a0[reg] * rs + be0; lp[16 + c] = a1[reg] * rs + be1;
                if (c < 4) lp[32 + c] = a2[reg] * rs + bg;
            }
        }
        __syncthreads();
        if (t < 64) {
            const LAS float* lp = logits + t * 48;
            int gi = 0; float mx = lp[32];
            for (int j = 1; j < 4; ++j) if (lp[32 + j] > mx) { mx = lp[32 + j]; gi = j; }
            float sum = 0.f;
            for (int j = 0; j < 4; ++j) sum += __expf(lp[32 + j] - mx);
            const float gval = 1.0f / sum;
            const LAS float* el = lp + gi * 8;
            int i1 = 0; float v1 = el[0];
            for (int j = 1; j < 8; ++j) if (el[j] > v1) { v1 = el[j]; i1 = j; }
            int i2 = 0; float v2 = -3.0e38f;
            for (int j = 0; j < 8; ++j) if (j != i1 && el[j] > v2) { v2 = el[j]; i2 = j; }
            const float e2 = __expf(v2 - v1);
            sel_e[2 * t] = gi * 8 + i1; sel_e[2 * t + 1] = gi * 8 + i2;
            sel_w[2 * t] = gval / (1.0f + e2); sel_w[2 * t + 1] = gval * e2 / (1.0f + e2);
        }
        __syncthreads();
        if (t < 128) {
            const int e = sel_e[t]; int rank = 0;
            for (int j = 0; j < t; ++j) rank += (sel_e[j] == e) ? 1 : 0;
            tok_e[tok0 * 2 + t] = e; tok_rank[tok0 * 2 + t] = rank; tok_w[tok0 * 2 + t] = sel_w[t];
        } else if (t < 160) {
            const int e = t - 128; int cnt = 0;
            for (int j = 0; j < 128; ++j) cnt += (sel_e[j] == e) ? 1 : 0;
            wgcnt[grp * 32 + e] = cnt;
        }
    }
}
__device__ __forceinline__ void moe_tables(const char* route, LAS unsigned char* lds) {
    LAS int* tstart = (LAS int*)(lds + LDS_MOE); LAS int* tot = tstart + 64;
    const int* wgcnt = (const int*)(route + R_WGCNT);
    const int t = fresh_tid();
    if (t < 32) { int s = 0; for (int g = 0; g < NTOK / 64; ++g) s += wgcnt[g * 32 + t]; tot[t] = s; }
    __syncthreads();
    if (t == 0) { int acc = 0; for (int e = 0; e < 32; ++e) { tstart[e] = acc; acc += (tot[e] + 255) >> 8; } tstart[32] = acc; }
    __syncthreads();
}
__device__ __forceinline__ void ph_gather(const Params& p, const float* __restrict__ x1, char* route, bf16_t* xs, LAS unsigned char* lds) {
    LAS int* tstart = (LAS int*)(lds + LDS_MOE); LAS int* bef = tstart + 128;
    const int* wgcnt = (const int*)(route + R_WGCNT); const int* tok_e = (const int*)(route + R_TOKE); const int* tok_rank = (const int*)(route + R_TOKRANK);
    const float* tok_w = (const float*)(route + R_TOKW); const float* rstd_i = (const float*)(route + R_RSTD);
    int* slot_tok = (int*)(route + R_SLOTTOK); float* slot_w = (float*)(route + R_SLOTW);
    const int t = fresh_tid(), wid = t >> 6, lane = t & 63;
    moe_tables(route, lds);
    for (int grp = blockIdx.x; grp < NTOK / 64; grp += gridDim.x) {
        __syncthreads();
        if (t < 32) { int s = 0; for (int g = 0; g < grp; ++g) s += wgcnt[g * 32 + t]; bef[t] = s; }
        __syncthreads();
        for (int j = wid; j < 128; j += 8) {
            const int tok = grp * 64 + (j >> 1), ch = j & 1;
            const int e = tok_e[tok * 2 + ch];
            const int slot = tstart[e] * 256 + bef[e] + tok_rank[tok * 2 + ch];
            const float rs = rstd_i[tok];
#pragma unroll
            for (int jj = 0; jj < 4; ++jj) {
                const float4 v = ((const float4*)(x1 + (size_t)tok * DM))[lane + 64 * jj];
                const float4 gg = ((const float4*)p.g_ffn)[lane + 64 * jj];
                uint2 o; o.x = pk2(v.x * rs * gg.x, v.y * rs * gg.y); o.y = pk2(v.z * rs * gg.z, v.w * rs * gg.w);
                ((uint2*)(xs + (size_t)slot * DM))[lane + 64 * jj] = o;
            }
            if (lane == 0) { slot_tok[slot] = ch * NTOK + tok; slot_w[slot] = tok_w[tok * 2 + ch]; }
        }
    }
}
struct MoeOrder {
    const LAS int* tstart; int G, c, nunits;
    __device__ __forceinline__ bool next(int i, pg8::Unit& u) const {
        const long L = (long)i * G + c; if (L >= nunits) return false;
        const int T = (int)(L >> 2), nt = (int)(L & 3); int e = 0;
        for (int j = 1; j < 32; ++j) e += (tstart[j] <= T) ? 1 : 0;
        u.pm = T; u.pn = e * 4 + nt; return true;
    }
    __device__ __forceinline__ void a_ready(const pg8::Unit&) const {}
    __device__ __forceinline__ void done(const pg8::Unit&) const {}
};
struct EpiMoe1 {
    static constexpr bool PERM = true, AFTER_DRAIN = false;
    bf16_t* hid; const float* slot_w;
    __device__ __forceinline__ void operator()(const f32x4 (&acc)[2][2][4][2], const pg8::Unit& u, int wr, int wc, int fr, int fq) const {
        const int row0 = u.pm * 256 + wr * 64 + fr, f0 = (u.pn & 3) * 128 + wc * 16 + 4 * fq;
#pragma unroll
        for (int ai = 0; ai < 2; ++ai)
#pragma unroll
            for (int m = 0; m < 4; ++m) {
                const int row = row0 + ai * 128 + m * 16;
                const float w = slot_w[row];
#pragma unroll
                for (int bj = 0; bj < 2; ++bj) {
                    const f32x4 g = acc[ai][bj][m][0], up = acc[ai][bj][m][1];
                    float o[4];
#pragma unroll
                    for (int i = 0; i < 4; ++i) o[i] = g[i] * sigmoidf_fast(g[i]) * up[i] * w;
                    uint2 pk; pk.x = pk2(o[0], o[1]); pk.y = pk2(o[2], o[3]);
                    *(uint2*)(hid + (size_t)row * 512 + f0 + bj * 64) = pk;
                }
            }
    }
};
struct EpiMoe2 {
    static constexpr bool PERM = true, AFTER_DRAIN = false;
    bf16_t* y01; const int* slot_tok; const LAS int* tstart; const LAS int* tot;
    __device__ __forceinline__ void operator()(const f32x4 (&acc)[2][2][4][2], const pg8::Unit& u, int wr, int wc, int fr, int fq) const {
        const int e = u.pn >> 2, nvalid = tot[e] - (u.pm - tstart[e]) * 256;
        const int lrow0 = wr * 64 + fr, col0 = (u.pn & 3) * 256 + wc * 32 + 8 * fq;
#pragma unroll
        for (int ai = 0; ai < 2; ++ai)
#pragma unroll
            for (int m = 0; m < 4; ++m) {
                const int lrow = lrow0 + ai * 128 + m * 16;
                if (lrow < nvalid) {
                    const int dst = slot_tok[u.pm * 256 + lrow];
                    bf16_t* rowp = y01 + (size_t)dst * 1024 + col0;
#pragma unroll
                    for (int bj = 0; bj < 2; ++bj) {
                        const f32x4 v0 = acc[ai][bj][m][0], v1 = acc[ai][bj][m][1];
                        u32x4 o; o.x = pk2(v0[0], v0[1]); o.y = pk2(v0[2], v0[3]); o.z = pk2(v1[0], v1[1]); o.w = pk2(v1[2], v1[3]);
                        *(u32x4*)(rowp + bj * 128) = o;
                    }
                }
            }
    }
};
__device__ __forceinline__ void ph_final(const float* __restrict__ x1, const bf16_t* __restrict__ y01, const float* __restrict__ g, float* __restrict__ out) {
    const int tid_ = fresh_tid(); const int lane = tid_ & 63, gw = blockIdx.x * 8 + (tid_ >> 6), ngw = gridDim.x * 8;
    for (int row = gw; row < NTOK; row += ngw) {
        float4 v[4]; float ss = 0.f;
#pragma unroll
        for (int j = 0; j < 4; ++j) {
            v[j] = ((const float4*)(x1 + (size_t)row * DM))[lane + 64 * j];
            const uint2 a = ((const uint2*)(y01 + (size_t)row * DM))[lane + 64 * j];
            const uint2 b = ((const uint2*)(y01 + (size_t)(NTOK + row) * DM))[lane + 64 * j];
            v[j].x += bflo(a.x) + bflo(b.x); v[j].y += bfhi(a.x) + bfhi(b.x); v[j].z += bflo(a.y) + bflo(b.y); v[j].w += bfhi(a.y) + bfhi(b.y);
            ss += v[j].x * v[j].x + v[j].y * v[j].y + v[j].z * v[j].z + v[j].w * v[j].w;
        }
        ss = wave_sum(ss);
        const float r = rsqrtf(ss * (1.0f / DM) + 1e-6f);
#pragma unroll
        for (int j = 0; j < 4; ++j) {
            const float4 gg = ((const float4*)g)[lane + 64 * j];
            float4 o; o.x = v[j].x * r * gg.x; o.y = v[j].y * r * gg.y; o.z = v[j].z * r * gg.z; o.w = v[j].w * r * gg.w;
            ((float4*)(out + (size_t)row * DM))[lane + 64 * j] = o;
        }
    }
}

__global__ void __launch_bounds__(NTHR, 2) fwd_megakernel(Params p) {
    extern __shared__ __attribute__((aligned(16))) unsigned char lds_raw[];
    LAS unsigned char* lds = (LAS unsigned char*)lds_raw;
    cg::grid_group grid = cg::this_grid();
    char* ws = p.ws; char* ob = p.ob;
    bf16_t* WinT = (bf16_t*)(ws + WS_WINT * MiB);
    bf16_t* PAt = (bf16_t*)(ws + WS_PAT * MiB);
    bf16_t* PRt = (bf16_t*)(ws + WS_PRT * MiB);
    bf16_t* WoT = (bf16_t*)(ws + WS_WOT * MiB);
    bf16_t* qa = (bf16_t*)(ws + WS_QA * MiB);
    bf16_t* ka = (bf16_t*)(ws + WS_KA * MiB);
    bf16_t* va = (bf16_t*)(ws + WS_VA * MiB);
    bf16_t* qr = (bf16_t*)(ws + WS_QR * MiB);
    bf16_t* kr = (bf16_t*)(ws + WS_KR * MiB);
    bf16_t* vr = (bf16_t*)(ws + WS_VR * MiB);
    bf16_t* gsw = (bf16_t*)(ws + WS_GSW * MiB);
    bf16_t* ga = (bf16_t*)(ws + WS_GA * MiB);
    bf16_t* oattn = (bf16_t*)(ws + WS_OATTN * MiB);
    bf16_t* hb = (bf16_t*)(ob + 0 * MiB);
    bf16_t* gr = (bf16_t*)(ob + 32 * MiB);
    bf16_t* oret = (bf16_t*)(ws + WS_ORET * MiB);
    bf16_t* merged = (bf16_t*)(ws + WS_MERGED * MiB);
    float* x1 = (float*)(ws + WS_X1 * MiB);
    const int G = gridDim.x;

    ph_transpose_all(p.w_in, 1024, 9728, 1, WinT, lds);
    ph_transpose_all(p.w_ab, 512, 1024, 1, PAt, lds);
    ph_transpose_all(p.w_rb, 1024, 1024, 1, PRt, lds);
    ph_transpose_all(p.w_out, 1024, 1024, 1, WoT, lds);
    ph_rmsnorm_bf16(p.x, p.g_mix, hb);
    grid.sync();
    {
        pg8::Gemm g{hb, WinT, NTOK, 9728, 1024}; pg8::StaticOrder S; S.init(NTOK, 9728, G, (int)blockIdx.x);
        EpiProj E{ws, ob};
        pg8::gemm_phase<EpiProj, pg8::StaticOrder, true, true>(lds, g, S, E);
    }
    grid.sync();
    ph_attn(qa, ka, va, oattn, lds);
    grid.sync();
    float* KVf = (float*)(ws + WS_KVF * MiB);
    bf16_t* ST = (bf16_t*)(ws + WS_ST * MiB);
    ph_ret_kv(kr, vr, KVf, lds);
    grid.sync();
    ph_ret_scan(KVf, ST);
    grid.sync();
    ph_ret_out(qr, kr, vr, ST, gsw, oret, lds);
    grid.sync();
    {
        pg8::Gemm g{oattn, PAt, NTOK, 1024, 512}; pg8::StaticOrder S; S.init(NTOK, 1024, G, (int)blockIdx.x);
        EpiGate E{ga, merged, 0};
        pg8::gemm_phase<EpiGate, pg8::StaticOrder, true, true>(lds, g, S, E);
    }
    {
        pg8::Gemm g{oret, PRt, NTOK, 1024, 1024}; pg8::StaticOrder S; S.init(NTOK, 1024, G, (int)blockIdx.x);
        EpiGate E{gr, merged, 1};
        pg8::gemm_phase<EpiGate, pg8::StaticOrder, true, true>(lds, g, S, E);
    }
    grid.sync();
    {
        pg8::Gemm g{merged, WoT, NTOK, 1024, 1024}; pg8::StaticOrder S; S.init(NTOK, 1024, G, (int)blockIdx.x);
        EpiResid E{p.x, x1};
        pg8::gemm_phase<EpiResid, pg8::StaticOrder, true, true>(lds, g, S, E);
    }
    grid.sync();
    char* route = ws + WS_ROUTE * MiB;
    bf16_t* WguT = (bf16_t*)(ws + WS_WGU * MiB);
    bf16_t* WdT = (bf16_t*)(ws + WS_WD * MiB);
    bf16_t* xs = (bf16_t*)(ws + WS_XS * MiB);
    bf16_t* y01 = (bf16_t*)(ws + WS_Y01 * MiB);
    bf16_t* hid = (bf16_t*)(ob);
    ph_transpose_gu(p.w_gate, p.w_up, WguT, lds);
    ph_transpose_all(p.w_down, 512, 1024, 32, WdT, lds);
    ph_route(p, x1, route, lds);
    grid.sync();
    ph_gather(p, x1, route, xs, lds);
    grid.sync();
    const LAS int* tstart = (const LAS int*)(lds + LDS_MOE); const LAS int* tot = tstart + 64;
    {
        pg8::Gemm g{xs, WguT, 40960, 32 * 1024, 1024}; MoeOrder S{tstart, G, (int)blockIdx.x, tstart[32] * 4};
        EpiMoe1 E{hid, (const float*)(route + R_SLOTW)};
        pg8::gemm_phase<EpiMoe1, MoeOrder, true, true>(lds, g, S, E);
    }
    grid.sync();
    {
        pg8::Gemm g{hid, WdT, 40960, 32 * 1024, 512}; MoeOrder S{tstart, G, (int)blockIdx.x, tstart[32] * 4};
        EpiMoe2 E{y01, (const int*)(route + R_SLOTTOK), tstart, tot};
        pg8::gemm_phase<EpiMoe2, MoeOrder, true, true>(lds, g, S, E);
    }
    grid.sync();
    ph_final(x1, y01, p.g_final, p.out);
}

extern "C" void kernel_launch(void* const* d_in, const int* in_sizes, int n_in, void* d_out, int out_size, void* d_ws, size_t ws_size, hipStream_t stream) {
    static int grid_blocks = 0;
    if (!grid_blocks) {
        int dev = 0, cus = 0, per_cu = 0;
        (void)hipGetDevice(&dev);
        (void)hipDeviceGetAttribute(&cus, hipDeviceAttributeMultiprocessorCount, dev);
        (void)hipFuncSetAttribute((const void*)fwd_megakernel, hipFuncAttributeMaxDynamicSharedMemorySize, LDS_BYTES);
        (void)hipOccupancyMaxActiveBlocksPerMultiprocessor(&per_cu, (const void*)fwd_megakernel, NTHR, LDS_BYTES);
        if (per_cu > 1) per_cu = 1;
        grid_blocks = cus * per_cu;
        if (grid_blocks <= 0 || ws_size < WS_END * MiB) { fprintf(stderr, "kernel_launch: cannot launch (grid %d, ws %zu)\n", grid_blocks, ws_size); grid_blocks = -1; }
    }
    if (grid_blocks < 0) return;
    Params p{};
    p.x = (const float*)d_in[0]; p.g_mix = (const float*)d_in[1]; p.w_in = (const float*)d_in[2]; p.w_ab = (const float*)d_in[3];
    p.w_rb = (const float*)d_in[4]; p.w_out = (const float*)d_in[5]; p.g_ffn = (const float*)d_in[6]; p.w_gr = (const float*)d_in[7];
    p.b_gr = (const float*)d_in[8]; p.w_er = (const float*)d_in[9]; p.b_er = (const float*)d_in[10]; p.w_gate = (const float*)d_in[11];
    p.w_up = (const float*)d_in[12]; p.w_down = (const float*)d_in[13]; p.g_final = (const float*)d_in[14];
    p.out = (float*)d_out; p.ws = (char*)d_ws; p.ob = (char*)d_out;
    void* args[] = {&p};
    hipError_t e = hipLaunchCooperativeKernel((const void*)fwd_megakernel, dim3(grid_blocks), dim3(NTHR), args, LDS_BYTES, stream);
    if (e != hipSuccess) fprintf(stderr, "cooperative launch failed: %s (grid %d)\n", hipGetErrorString(e), grid_blocks);
}
```

```cpp
#include <hip/hip_runtime.h>
#include <hip/hip_cooperative_groups.h>
#include <stdint.h>
#include <cstdio>
namespace cg = cooperative_groups;

namespace pg8 {
#define PG8_LAS __attribute__((address_space(3)))
typedef unsigned short bf16_t;
typedef short bf16x8 __attribute__((ext_vector_type(8)));
typedef float f32x4 __attribute__((ext_vector_type(4)));
typedef unsigned u32x4 __attribute__((ext_vector_type(4)));
constexpr int BM = 256, BK = 64, HALF = 128, HTB = HALF * BK * 2  , STAGE_BYTES = 8 * HTB, NXCD = 8, WGM = 8;

__host__ __device__ __forceinline__ int lds_byte(int r, int c) { const int st = (r >> 4) * 2 + (c >> 5), rr = r & 15, cc = c & 31, ob = rr * 64 + cc * 2; return st * 1024 + (ob ^ (((ob >> 9) & 1) << 5)); }
__host__ __device__ __forceinline__ void stage_rc(int b, int& R, int& C) { const int st = b / 1024, sb = b % 1024, swz = sb ^ (((sb >> 9) & 1) << 5); R = (st >> 1) * 16 + swz / 64; C = (st & 1) * 32 + (swz % 64) / 2; }
__host__ __device__ __forceinline__ int perm32(int rho) { const int n = rho >> 4, i = rho & 15; return 8 * (i >> 2) + 4 * n + (i & 3); }

__device__ __forceinline__ int pg8_fresh_tid() { int t = threadIdx.x; asm volatile("" : "+v"(t)); return t; }
struct Unit { int pm, pn; };
struct Gemm { const bf16_t* A; const bf16_t* Bt; int M, N, K; };

struct StaticOrder {
    int nM, nN, nwg, G, c;
    __host__ __device__ void init(int M, int N, int G_, int c_) { nM = M / BM; nN = N / BM; nwg = nM * nN; G = G_; c = c_; }
    __host__ __device__ bool next(int i, Unit& u) const {
        const long L = (long)i * G + c; if (L >= nwg) return false;
        int wgid = (int)L; { const int q = nwg / NXCD, r = nwg % NXCD, xcd = wgid % NXCD, off = wgid / NXCD; wgid = (xcd < r ? xcd * (q + 1) : r * (q + 1) + (xcd - r) * q) + off; }
        const int nig = WGM * nN, gid = wgid / nig, fm = gid * WGM, gsz = (nM - fm) < WGM ? (nM - fm) : WGM;
        u.pm = fm + ((wgid % nig) % gsz); u.pn = (wgid % nig) / gsz; return true;
    }
    __device__ __forceinline__ void a_ready(const Unit&) const {}
    __device__ __forceinline__ void done(const Unit&) const {}
};

__device__ __forceinline__ unsigned cvt_pk_bf16(float lo, float hi) { unsigned r; asm volatile("v_cvt_pk_bf16_f32 %0, %1, %2" : "=v"(r) : "v"(lo), "v"(hi)); return r; }

template <class Epi, class Sched, bool ALIGN_EPI = false, bool SP2 = false>
__device__ __forceinline__ void gemm_phase(PG8_LAS unsigned char* lds, const Gemm g, const Sched& S, const Epi& E) {
    const int tid = pg8_fresh_tid(), wid = __builtin_amdgcn_readfirstlane(tid >> 6), lane = tid & 63, wr = wid >> 2, wc = wid & 3, fr = lane & 15, fq = lane >> 4;
    const int K = g.K, nt = K / BK;
    unsigned voffA[2], voffB[2];
#pragma unroll
    for (int i = 0; i < 2; ++i) { int R, C; stage_rc(tid * 16 + i * 8192, R, C); const int Rb = Epi::PERM ? ((R & ~31) + perm32(R & 31)) : R;
        voffA[i] = (unsigned)(R * K + C) * 2u; voffB[i] = (unsigned)(Rb * K + C) * 2u; }
    const size_t kstep = (size_t)(BK * 2);
    const size_t hstep = (size_t)HALF * K * 2;
    const size_t tstep = 2 * hstep;
    const unsigned ldsw = (unsigned)wid * 1024u;
    const int aoff = lds_byte(wr * 64 + fr, fq * 8), boff = lds_byte(wc * 32 + fr, fq * 8);
#define PG8_SA(b, h) (((b) * 2 + (h)) * HTB)
#define PG8_SB(b, h) ((4 + (b) * 2 + (h)) * HTB)
#define PG8_STAGE(bufoff, gbase, voff) do { _Pragma("unroll") for (int _i = 0; _i < 2; ++_i) \
        __builtin_amdgcn_global_load_lds((const unsigned*)((const char*)(gbase) + (voff)[_i]), (PG8_LAS unsigned*)(lds + (bufoff) + ldsw + _i * 8192), 16, 0, 0); } while (0)
#define PG8_LDA(dst, b, h) do { _Pragma("unroll") for (int m = 0; m < 4; ++m) _Pragma("unroll") for (int k = 0; k < 2; ++k) dst[m][k] = *(const PG8_LAS bf16x8*)(lds + PG8_SA(b, h) + aoff + m * 2048 + k * 1024); } while (0)
#define PG8_LDB(dst, b, h) do { _Pragma("unroll") for (int n = 0; n < 2; ++n) _Pragma("unroll") for (int k = 0; k < 2; ++k) dst[n][k] = *(const PG8_LAS bf16x8*)(lds + PG8_SB(b, h) + boff + n * 2048 + k * 1024); } while (0)
#define PG8_MMA(ai, bj, At, Bt) do { __builtin_amdgcn_s_setprio(1); _Pragma("unroll") for (int m = 0; m < 4; ++m) _Pragma("unroll") for (int n = 0; n < 2; ++n) _Pragma("unroll") for (int k = 0; k < 2; ++k) \
        acc[ai][bj][m][n] = __builtin_amdgcn_mfma_f32_16x16x32_bf16(Bt[n][k], At[m][k], acc[ai][bj][m][n], 0, 0, 0); __builtin_amdgcn_s_setprio(0); } while (0)
#define PG8_WAIT_V(n) asm volatile("s_waitcnt vmcnt(" #n ")" ::: "memory")
#define PG8_WAIT_L(n) asm volatile("s_waitcnt lgkmcnt(" #n ")" ::: "memory")
#define PG8_BAR __builtin_amdgcn_s_barrier()
#define PG8_SCHED __builtin_amdgcn_sched_barrier(0)
    Unit cur, nxt; int ui = 0;
    if (!S.next(0, cur)) return;
    f32x4 acc[2][2][4][2];
#pragma unroll
    for (int a = 0; a < 2; ++a)
#pragma unroll
        for (int b = 0; b < 2; ++b)
#pragma unroll
            for (int m = 0; m < 4; ++m)
#pragma unroll
                for (int n = 0; n < 2; ++n) acc[a][b][m][n] = (f32x4){0.f, 0.f, 0.f, 0.f};
    bf16x8 At[4][2], B0[2][2], B1[2][2];
    const char* cA = (const char*)g.A + (size_t)cur.pm * tstep; const char* cB = (const char*)g.Bt + (size_t)cur.pn * tstep;
    S.a_ready(cur);
    if constexpr (SP2) {
        PG8_STAGE(PG8_SB(0, 0), cB, voffB); PG8_STAGE(PG8_SB(0, 1), cB + hstep, voffB); PG8_STAGE(PG8_SA(0, 0), cA, voffA); PG8_STAGE(PG8_SA(0, 1), cA + hstep, voffA);
        if (wr == 1) PG8_BAR;
        PG8_WAIT_V(2); PG8_BAR;
        PG8_STAGE(PG8_SB(1, 0), cB + kstep, voffB); PG8_STAGE(PG8_SA(1, 0), cA + kstep, voffA); PG8_STAGE(PG8_SB(1, 1), cB + hstep + kstep, voffB);
        PG8_WAIT_V(6); PG8_BAR;
    } else {
        PG8_STAGE(PG8_SB(0, 0), cB, voffB); PG8_STAGE(PG8_SA(0, 0), cA, voffA); PG8_STAGE(PG8_SB(0, 1), cB + hstep, voffB); PG8_STAGE(PG8_SA(0, 1), cA + hstep, voffA);
        if (wr == 1) PG8_BAR;
        PG8_WAIT_V(4); PG8_BAR;
        PG8_STAGE(PG8_SB(1, 0), cB + kstep, voffB); PG8_STAGE(PG8_SA(1, 0), cA + kstep, voffA); PG8_STAGE(PG8_SB(1, 1), cB + hstep + kstep, voffB);
        PG8_WAIT_V(6); PG8_BAR;
    }
    for (;;) {
        const bool has_next = S.next(ui + 1, nxt);
        const char* nA = has_next ? (const char*)g.A + (size_t)nxt.pm * tstep : cA; const char* nB = has_next ? (const char*)g.Bt + (size_t)nxt.pn * tstep : cB;
        for (int t = 0; t < nt; t += 2) {
            const bool last = (t == nt - 2);
            const char* a1 = cA + (size_t)(t + 1) * kstep;
            const char* a2 = last ? nA : cA + (size_t)(t + 2) * kstep; const char* b2 = last ? nB : cB + (size_t)(t + 2) * kstep;
            const char* a3 = a2 + kstep; const char* b3 = b2 + kstep;
            if (last && has_next) S.a_ready(nxt);
            if constexpr (SP2) {
            PG8_LDB(B0, 0, 0); PG8_LDB(B1, 0, 1); PG8_SCHED; PG8_LDA(At, 0, 0); PG8_STAGE(PG8_SA(1, 1), a1 + hstep, voffA);
            PG8_WAIT_V(8); PG8_WAIT_L(0); PG8_BAR; PG8_MMA(0, 0, At, B0); PG8_MMA(0, 1, At, B1); PG8_BAR; PG8_SCHED;
            PG8_LDA(At, 0, 1); PG8_STAGE(PG8_SB(0, 0), b2, voffB); PG8_STAGE(PG8_SB(0, 1), b2 + hstep, voffB); PG8_STAGE(PG8_SA(0, 0), a2, voffA);
            PG8_WAIT_V(8); PG8_WAIT_L(0); PG8_BAR; PG8_MMA(1, 0, At, B0); PG8_MMA(1, 1, At, B1); PG8_BAR; PG8_SCHED;
            PG8_LDB(B0, 1, 0); PG8_LDB(B1, 1, 1); PG8_SCHED; PG8_LDA(At, 1, 0); PG8_STAGE(PG8_SA(0, 1), a2 + hstep, voffA);
            PG8_WAIT_V(8); PG8_WAIT_L(0); PG8_BAR; PG8_MMA(0, 0, At, B0); PG8_MMA(0, 1, At, B1); PG8_BAR; PG8_SCHED;
            PG8_LDA(At, 1, 1); PG8_STAGE(PG8_SB(1, 0), b3, voffB); PG8_STAGE(PG8_SB(1, 1), b3 + hstep, voffB); PG8_STAGE(PG8_SA(1, 0), a3, voffA);
            PG8_WAIT_V(8); PG8_WAIT_L(0); PG8_BAR; PG8_MMA(1, 0, At, B0); PG8_MMA(1, 1, At, B1); PG8_BAR; PG8_SCHED;
            } else {
            PG8_LDB(B0, 0, 0); PG8_SCHED; PG8_LDA(At, 0, 0); PG8_STAGE(PG8_SA(1, 1), a1 + hstep, voffA);
            PG8_WAIT_L(8); PG8_BAR; PG8_WAIT_L(0); PG8_MMA(0, 0, At, B0); PG8_BAR; PG8_SCHED;
            PG8_LDB(B1, 0, 1); PG8_STAGE(PG8_SB(0, 0), b2, voffB);
            PG8_BAR; PG8_WAIT_L(0); PG8_MMA(0, 1, At, B1); PG8_BAR;
            PG8_LDA(At, 0, 1); PG8_STAGE(PG8_SA(0, 0), a2, voffA);
            PG8_BAR; PG8_WAIT_L(0); PG8_MMA(1, 0, At, B0); PG8_BAR; PG8_SCHED;
            PG8_STAGE(PG8_SB(0, 1), b2 + hstep, voffB);
            PG8_WAIT_V(6); PG8_BAR; PG8_MMA(1, 1, At, B1); PG8_BAR;
            PG8_LDB(B0, 1, 0); PG8_SCHED; PG8_LDA(At, 1, 0); PG8_STAGE(PG8_SA(0, 1), a2 + hstep, voffA);
            PG8_WAIT_L(8); PG8_BAR; PG8_WAIT_L(0); PG8_MMA(0, 0, At, B0); PG8_BAR; PG8_SCHED;
            PG8_LDB(B1, 1, 1); PG8_STAGE(PG8_SB(1, 0), b3, voffB);
            PG8_BAR; PG8_WAIT_L(0); PG8_MMA(0, 1, At, B1); PG8_BAR;
            PG8_LDA(At, 1, 1); PG8_STAGE(PG8_SA(1, 0), a3, voffA);
            PG8_BAR; PG8_WAIT_L(0); PG8_MMA(1, 0, At, B0); PG8_BAR; PG8_SCHED;
            PG8_STAGE(PG8_SB(1, 1), b3 + hstep, voffB);
            PG8_WAIT_V(6); PG8_BAR; PG8_MMA(1, 1, At, B1); PG8_BAR;
            }
        }
        if constexpr (ALIGN_EPI) { if (wr == 0) PG8_BAR; }
        if constexpr (!Epi::AFTER_DRAIN) { E(acc, cur, wr, wc, fr, fq); S.done(cur); }
        if (!has_next) break;
#pragma unroll
        for (int a = 0; a < 2; ++a)
#pragma unroll
            for (int b = 0; b < 2; ++b)
#pragma unroll
                for (int m = 0; m < 4; ++m)
#pragma unroll
                    for (int n = 0; n < 2; ++n) acc[a][b][m][n] = (f32x4){0.f, 0.f, 0.f, 0.f};
        cur = nxt; cA = nA; cB = nB; ++ui;
        if constexpr (ALIGN_EPI) { if (wr == 1) PG8_BAR; }
    }
    PG8_WAIT_V(0);
    if constexpr (!ALIGN_EPI) { if (wr == 0) PG8_BAR; }
    PG8_BAR;
    if constexpr (Epi::AFTER_DRAIN) { E.fused(acc, cur, wr, wc, fr, fq, lds, wid, lane); S.done(cur); }
#undef PG8_SA
#undef PG8_SB
#undef PG8_STAGE
#undef PG8_LDA
#undef PG8_LDB
#undef PG8_MMA
#undef PG8_WAIT_V
#undef PG8_WAIT_L
#undef PG8_BAR
#undef PG8_SCHED
}
}


using pg8::bf16_t;
using pg8::bf16x8;
using pg8::f32x4;
using pg8::u32x4;
#define LAS __attribute__((address_space(3)))
#define GAS __attribute__((address_space(1)))
typedef unsigned v4u __attribute__((ext_vector_type(4)));

#define NTOK 16384
#define SEQ 4096
#define DM 1024
#define NTHR 512
#define LDS_BYTES 147456
constexpr size_t MiB = (size_t)1 << 20;
constexpr size_t WS_CTL = 0, WS_WINT = 1, WS_PAT = 20, WS_PRT = 21, WS_WOT = 23;
constexpr size_t WS_KA = 26, WS_VA = 74, WS_QR = 122, WS_KR = 138, WS_VR = 154, WS_QA = 186, WS_GSW = 234, WS_GA = 266, WS_END = 298;
constexpr size_t WS_OATTN = 1;
constexpr size_t WS_ORET = 90;
constexpr size_t WS_X1 = 122;
constexpr size_t WS_MERGED = 186;
constexpr size_t WS_ROUTE = 17;
constexpr size_t WS_WGU = 26, WS_WD = 90;
constexpr size_t WS_XS = 186;
constexpr size_t WS_Y01 = 186;
constexpr size_t R_WGCNT = 0, R_TOKE = 65536, R_TOKRANK = 196608, R_TOKW = 327680, R_RSTD = 458752, R_SLOTTOK = 524288, R_SLOTW = 720896;
constexpr int LDS_BARST = 131072 + 2048;
constexpr size_t CTL_ZERO_BYTES = 65536;
constexpr int LDS_MOE = 131072;

__device__ __forceinline__ bf16_t f2bf(float f) { unsigned u = __float_as_uint(f); return (bf16_t)((u + 0x7fffu + ((u >> 16) & 1u)) >> 16); }
__device__ __forceinline__ unsigned pk2(float lo, float hi) { return (unsigned)f2bf(lo) | ((unsigned)f2bf(hi) << 16); }
__device__ __forceinline__ float bf2f(bf16_t h) { return __uint_as_float(((unsigned)h) << 16); }
__device__ __forceinline__ float bflo(unsigned w) { return __uint_as_float(w << 16); }
__device__ __forceinline__ float bfhi(unsigned w) { return __uint_as_float(w & 0xffff0000u); }
__device__ __forceinline__ float wave_sum(float v) {
#pragma unroll
    for (int o = 32; o >= 1; o >>= 1) v += __shfl_xor(v, o);
    return v;
}
__device__ __forceinline__ float sigmoidf_fast(float g) { return __builtin_amdgcn_rcpf(1.0f + __expf(-g)); }
#define LDS_WAIT() asm volatile("s_waitcnt lgkmcnt(0)" ::: "memory")
__device__ __forceinline__ int fresh_tid() { int t = threadIdx.x; asm volatile("" : "+v"(t)); return t; }

#define XB_TMO      128
#define XB_XCNT(j)  (256  + 64 * (j))
#define XB_XSUB(j)  (1280 + 64 * (j))
#define XB_XGEN(j)  (2304 + 64 * (j))
#define XB_TOP      3328
#define XB_TOPGEN   3392
#define XCD_BAR_WORDS 3456
#define XB_SPIN_CAP (1u << 18)

__device__ __forceinline__ unsigned xb_ld(unsigned* p)              { return __hip_atomic_load(p, __ATOMIC_RELAXED, __HIP_MEMORY_SCOPE_AGENT); }
__device__ __forceinline__ unsigned xb_add(unsigned* p, unsigned v) { return __hip_atomic_fetch_add(p, v, __ATOMIC_RELAXED, __HIP_MEMORY_SCOPE_AGENT); }
__device__ __forceinline__ unsigned xb_xcc_id() { return (unsigned)__builtin_amdgcn_s_getreg((3 << 11) | 20) & 0xFu; }
#define XB_SPIN(cond, bar) do { unsigned _sp = 0; while (cond) { __builtin_amdgcn_s_sleep(1); \
    if ((++_sp & 255u) == 0u) { if (xb_ld(&(bar)[XB_TMO])) break; if (_sp > XB_SPIN_CAP) { atomicAdd(&(bar)[XB_TMO], 1u); break; } } } } while (0)

struct XcdBarrier {
    unsigned* bar; unsigned x;
    volatile LAS unsigned* st;
};

__device__ __forceinline__ XcdBarrier xcd_barrier_post(unsigned* bar, volatile LAS unsigned* st) {
    XcdBarrier b; b.bar = bar; b.x = xb_xcc_id(); b.st = st;
    if (threadIdx.x == 0) (void)xb_add(&bar[XB_XCNT(b.x)], 1u);
    return b;
}
__device__ __forceinline__ void xcd_barrier_complete(unsigned* bar, unsigned x, unsigned& nloc, unsigned& nx) {
    const unsigned G = gridDim.x * gridDim.y * gridDim.z;
    unsigned sum, cnt, mine, sp = 0u;
    for (;;) {
        sum = 0u; cnt = 0u; mine = 0u;
#pragma unroll
        for (unsigned j = 0; j < 16; ++j) { const unsigned c = xb_ld(&bar[XB_XCNT(j)]); sum += c; cnt += (c > 0u) ? 1u : 0u; mine = (j == x) ? c : mine; }
        if (sum == G) break;
        __builtin_amdgcn_s_sleep(1);
        if ((++sp & 255u) == 0u) { if (xb_ld(&bar[XB_TMO])) break; if (sp > XB_SPIN_CAP) { atomicAdd(&bar[XB_TMO], 1u); break; } }
    }
    nloc = mine > 0u ? mine : 1u; nx = cnt > 0u ? cnt : 1u;
}

__device__ __forceinline__ void xcd_barrier(const XcdBarrier& b) {
    asm volatile("s_waitcnt vmcnt(0)" ::: "memory");
    __syncthreads();
    if (threadIdx.x == 0) {
        unsigned* bar = b.bar;
        __builtin_amdgcn_s_waitcnt(0);
        unsigned nloc = b.st[0], nx = b.st[1];
        if (nloc == 0u) { xcd_barrier_complete(bar, b.x, nloc, nx); b.st[0] = nloc; b.st[1] = nx; }
        const unsigned old = xb_add(&bar[XB_XSUB(b.x)], 1u);
        const unsigned gen = old / nloc;
        if (old + 1u == (gen + 1u) * nloc) {
            __builtin_amdgcn_fence(__ATOMIC_RELEASE, "agent");
            asm volatile("s_waitcnt vmcnt(0)" ::: "memory");
            const unsigned og = xb_add(&bar[XB_TOP], 1u);
            const unsigned tg = og / nx;
            if (og + 1u == (tg + 1u) * nx) xb_add(&bar[XB_TOPGEN], 1u);
            else XB_SPIN(xb_ld(&bar[XB_TOPGEN]) == tg, bar);
            __builtin_amdgcn_fence(__ATOMIC_ACQUIRE, "agent");
            xb_add(&bar[XB_XGEN(b.x)], 1u);
            asm volatile("s_waitcnt vmcnt(0)" ::: "memory");
        } else {
            XB_SPIN(xb_ld(&bar[XB_XGEN(b.x)]) == gen, bar);
            __builtin_amdgcn_fence(__ATOMIC_ACQUIRE, "agent");
            asm volatile("s_waitcnt vmcnt(0)" ::: "memory");
        }
    }
    __syncthreads();
}

struct Params {
    const float *x, *g_mix, *w_in, *w_ab, *w_rb, *w_out, *g_ffn, *w_gr, *b_gr, *w_er, *b_er, *w_gate, *w_up, *w_down, *g_final;
    float* out; char* ws; char* ob;
};

__device__ __forceinline__ float block_sum512(float v, float* red) {
    v = wave_sum(v);
    __syncthreads();
    if ((threadIdx.x & 63) == 0) red[threadIdx.x >> 6] = v;
    __syncthreads();
    float s = 0.f;
#pragma unroll
    for (int i = 0; i < 8; ++i) s += red[i];
    return s;
}

template <bool GU>
__device__ __forceinline__ void p0_transpose_item(const float* W, int K, int N, bf16_t* WT, int row_off, LAS float* scr, int item, int lane) {
    const int nblk = N / 32, kb = item / nblk, nb = item % nblk, k0 = 64 * kb, n0 = 32 * nb;
#pragma unroll 8
    for (int i = 0; i < 32; ++i) { const int kk = 2 * i + (lane >> 5); scr[kk * 33 + (lane & 31)] = W[(size_t)(k0 + kk) * N + n0 + (lane & 31)]; }
    LDS_WAIT(); asm volatile("" ::: "memory");
    const int c = lane & 7;
#pragma unroll
    for (int j = 0; j < 4; ++j) { const int n = (lane >> 3) + 8 * j; const LAS float* s = scr + (8 * c) * 33 + n;
        v4u o; o.x = pk2(s[0 * 33], s[1 * 33]); o.y = pk2(s[2 * 33], s[3 * 33]); o.z = pk2(s[4 * 33], s[5 * 33]); o.w = pk2(s[6 * 33], s[7 * 33]);
        const int drow = GU ? ((((n0 + n) >> 2) << 3) + ((n0 + n) & 3) + row_off) : (row_off + n0 + n);
        *(GAS v4u*)(WT + (size_t)drow * K + k0 + 8 * c) = o; }
    LDS_WAIT(); asm volatile("" ::: "memory");
}
__device__ __forceinline__ void ph_transpose_all(const float* W, int K, int N, int nmat, bf16_t* WT, LAS unsigned char* lds) {
    const int tid_ = fresh_tid(); const int wave = tid_ >> 6, lane = tid_ & 63;
    LAS float* scr = (LAS float*)(lds + wave * 16384);
    const int gw = blockIdx.x * 8 + wave, NGW = gridDim.x * 8;
    const int per = (K / 64) * (N / 32), total = per * nmat;
    for (int it = gw; it < total; it += NGW) {
        const int mi = it / per, r = it % per;
        p0_transpose_item<false>(W + (size_t)mi * K * N, K, N, WT + (size_t)mi * K * N, 0, scr, r, lane);
    }
}
__device__ __forceinline__ void ph_transpose_gu(const float* Wg, const float* Wu, bf16_t* WT, LAS unsigned char* lds) {
    const int tid_ = fresh_tid(); const int wave = tid_ >> 6, lane = tid_ & 63;
    LAS float* scr = (LAS float*)(lds + wave * 16384);
    const int gw = blockIdx.x * 8 + wave, NGW = gridDim.x * 8;
    const int per = (1024 / 64) * (512 / 32), total = per * 64;
    for (int it = gw; it < total; it += NGW) {
        const int mi = it / per, r = it % per, e = mi >> 1, up = mi & 1;
        p0_transpose_item<true>((up ? Wu : Wg) + (size_t)e * 1024 * 512, 1024, 512, WT + (size_t)e * 1024 * 1024, up * 4, scr, r, lane);
    }
}

__device__ __forceinline__ void ph_rmsnorm_bf16(const float* __restrict__ x, const float* __restrict__ g, bf16_t* __restrict__ out) {
    const int tid_ = fresh_tid(); const int lane = tid_ & 63, gw = blockIdx.x * 8 + (tid_ >> 6), ngw = gridDim.x * 8;
    for (int row = gw; row < NTOK; row += ngw) {
        float4 v[4]; float ss = 0.f;
#pragma unroll
        for (int j = 0; j < 4; ++j) { v[j] = ((const float4*)(x + (size_t)row * DM))[lane + 64 * j]; ss += v[j].x * v[j].x + v[j].y * v[j].y + v[j].z * v[j].z + v[j].w * v[j].w; }
        ss = wave_sum(ss);
        const float r = rsqrtf(ss * (1.0f / DM) + 1e-6f);
#pragma unroll
        for (int j = 0; j < 4; ++j) {
            const float4 gg = ((const float4*)g)[lane + 64 * j];
            uint2 o; o.x = pk2(v[j].x * r * gg.x, v[j].y * r * gg.y); o.y = pk2(v[j].z * r * gg.z, v[j].w * r * gg.w);
            ((uint2*)(out + (size_t)row * DM))[lane + 64 * j] = o;
        }
    }
}

struct EpiProj {
    static constexpr bool PERM = true, AFTER_DRAIN = false;
    char* ws; char* ob;
    __device__ __forceinline__ void operator()(const f32x4 (&acc)[2][2][4][2], const pg8::Unit& u, int wr, int wc, int fr, int fq) const {
        const int pn = u.pn;
        size_t off; int w, t0;
        if (pn < 6) { off = WS_QA * MiB; w = 1536; t0 = 0; }
        else if (pn < 12) { off = WS_KA * MiB; w = 1536; t0 = 6; }
        else if (pn < 18) { off = WS_VA * MiB; w = 1536; t0 = 12; }
        else if (pn < 20) { off = WS_QR * MiB; w = 512; t0 = 18; }
        else if (pn < 22) { off = WS_KR * MiB; w = 512; t0 = 20; }
        else if (pn < 26) { off = WS_VR * MiB; w = 1024; t0 = 22; }
        else if (pn < 30) { off = WS_GSW * MiB; w = 1024; t0 = 26; }
        else if (pn < 34) { off = WS_GA * MiB; w = 1024; t0 = 30; }
        else { off = 32 * MiB; w = 1024; t0 = 34; }
        bf16_t* base = (bf16_t*)((pn >= 34 ? ob : ws) + off);
        const float sc = (pn < 6) ? 0.18033688011112042f : 1.0f;
        const int row0 = u.pm * 256 + wr * 64 + fr, col0 = (pn - t0) * 256 + wc * 32 + 8 * fq;
#pragma unroll
        for (int ai = 0; ai < 2; ++ai)
#pragma unroll
            for (int m = 0; m < 4; ++m) {
                bf16_t* rowp = base + (size_t)(row0 + ai * 128 + m * 16) * w + col0;
#pragma unroll
                for (int bj = 0; bj < 2; ++bj) {
                    const f32x4 v0 = acc[ai][bj][m][0] * sc, v1 = acc[ai][bj][m][1] * sc;
                    u32x4 o; o.x = pk2(v0[0], v0[1]); o.y = pk2(v0[2], v0[3]); o.z = pk2(v1[0], v1[1]); o.w = pk2(v1[2], v1[3]);
                    *(u32x4*)(rowp + bj * 128) = o;
                }
            }
    }
};
struct EpiGate {
    static constexpr bool PERM = true, AFTER_DRAIN = false;
    const bf16_t* gate; bf16_t* merged; int accumulate;
    __device__ __forceinline__ void operator()(const f32x4 (&acc)[2][2][4][2], const pg8::Unit& u, int wr, int wc, int fr, int fq) const {
        const int row0 = u.pm * 256 + wr * 64 + fr, col0 = u.pn * 256 + wc * 32 + 8 * fq;
#pragma unroll
        for (int ai = 0; ai < 2; ++ai)
#pragma unroll
            for (int m = 0; m < 4; ++m)
#pragma unroll
                for (int bj = 0; bj < 2; ++bj) {
                    const size_t idx = (size_t)(row0 + ai * 128 + m * 16) * 1024 + col0 + bj * 128;
                    const u32x4 g = *(const u32x4*)(gate + idx);
                    const f32x4 v0 = acc[ai][bj][m][0], v1 = acc[ai][bj][m][1];
                    float o[8];
                    o[0] = v0[0] * sigmoidf_fast(bflo(g.x)); o[1] = v0[1] * sigmoidf_fast(bfhi(g.x));
                    o[2] = v0[2] * sigmoidf_fast(bflo(g.y)); o[3] = v0[3] * sigmoidf_fast(bfhi(g.y));
                    o[4] = v1[0] * sigmoidf_fast(bflo(g.z)); o[5] = v1[1] * sigmoidf_fast(bfhi(g.z));
                    o[6] = v1[2] * sigmoidf_fast(bflo(g.w)); o[7] = v1[3] * sigmoidf_fast(bfhi(g.w));
                    if (accumulate) {
                        const u32x4 p = *(const u32x4*)(merged + idx);
                        o[0] += bflo(p.x); o[1] += bfhi(p.x); o[2] += bflo(p.y); o[3] += bfhi(p.y);
                        o[4] += bflo(p.z); o[5] += bfhi(p.z); o[6] += bflo(p.w); o[7] += bfhi(p.w);
                    }
                    u32x4 w; w.x = pk2(o[0], o[1]); w.y = pk2(o[2], o[3]); w.z = pk2(o[4], o[5]); w.w = pk2(o[6], o[7]);
                    *(u32x4*)(merged + idx) = w;
                }
    }
};
struct EpiResid {
    static constexpr bool PERM = true, AFTER_DRAIN = false;
    const float* x; float* x1;
    __device__ __forceinline__ void operator()(const f32x4 (&acc)[2][2][4][2], const pg8::Unit& u, int wr, int wc, int fr, int fq) const {
        const int row0 = u.pm * 256 + wr * 64 + fr, col0 = u.pn * 256 + wc * 32 + 8 * fq;
#pragma unroll
        for (int ai = 0; ai < 2; ++ai)
#pragma unroll
            for (int m = 0; m < 4; ++m)
#pragma unroll
                for (int bj = 0; bj < 2; ++bj) {
                    const size_t idx = (size_t)(row0 + ai * 128 + m * 16) * 1024 + col0 + bj * 128;
                    const f32x4 a = *(const f32x4*)(x + idx), b = *(const f32x4*)(x + idx + 4);
                    *(f32x4*)(x1 + idx) = a + acc[ai][bj][m][0];
                    *(f32x4*)(x1 + idx + 4) = b + acc[ai][bj][m][1];
                }
    }
};


typedef short v4i16_t __attribute__((ext_vector_type(4)));
__device__ __forceinline__ unsigned cvtpk_bf16(float lo, float hi) {
    typedef float f32x2_t __attribute__((ext_vector_type(2))); typedef __bf16 bf16x2_t __attribute__((ext_vector_type(2)));
    f32x2_t v = {lo, hi}; bf16x2_t b = __builtin_convertvector(v, bf16x2_t); return __builtin_bit_cast(unsigned, b);
}
template <int NT>
__device__ __forceinline__ void attn_group(const bf16_t* __restrict__ qa, const bf16_t* __restrict__ ka, const bf16_t* __restrict__ va,
                                           int b, int h, int grp, int d, int rho, int L, const int* cq0, int cqstep, int ck_start, int nchunks, float bslope,
                                           f32x4* o  , float* m  , float* l  , LAS unsigned char* vbuf, int lane) {
    const int c = lane & 15, g = lane >> 4;
    const size_t hoff = (size_t)grp * 512 + h * 64;
    bf16x8 qf[NT][2]; int jl[NT], jmax[NT];
#pragma unroll
    for (int t = 0; t < NT; ++t) {
        const int cq = cq0[t] + cqstep * c;
        const bf16_t* qp = qa + (size_t)(b * SEQ + cq * d + rho) * 1536 + hoff + 8 * g;
        qf[t][0] = *(const bf16x8*)qp; qf[t][1] = *(const bf16x8*)(qp + 32);
        jl[t] = cq - ck_start - 4 * g; jmax[t] = cq < 128 ? cq : 128;
    }
    const int tq = c >> 2, tp = c & 3;
    const int vr0 = 4 * g + tq, vr1 = 16 + 4 * g + tq;
    const int vx0 = ((vr0 >> 1) & 3) << 1, vx1 = ((vr1 >> 1) & 3) << 1;
    int voff0[4], voff1[4];
#pragma unroll
    for (int n = 0; n < 4; ++n) {
        voff0[n] = vr0 * 128 + (((2 * n + (tp >> 1)) ^ vx0) << 4) + 8 * (tp & 1);
        voff1[n] = vr1 * 128 + (((2 * n + (tp >> 1)) ^ vx1) << 4) + 8 * (tp & 1);
    }
    const int dr = lane >> 3, dcp = lane & 7;
    auto issue_v = [&](int chunk, int buf) {
#pragma unroll
        for (int ii = 0; ii < 4; ++ii) {
            const int r = 8 * ii + dr;
            int ck = ck_start + 32 * chunk + r; ck = ck < 0 ? 0 : (ck > L - 1 ? L - 1 : ck);
            const int ch = dcp ^ (((r >> 1) & 3) << 1);
            const bf16_t* src = va + (size_t)(b * SEQ + ck * d + rho) * 1536 + hoff + ch * 8;
            __builtin_amdgcn_global_load_lds((const unsigned*)src, (LAS unsigned*)(vbuf + buf * 4096 + ii * 1024), 16, 0, 0);
        }
    };
    auto load_k = [&](int chunk, bf16x8* kf) {
#pragma unroll
        for (int kt = 0; kt < 2; ++kt) {
            int ck = ck_start + 32 * chunk + 16 * kt + c; ck = ck < 0 ? 0 : (ck > L - 1 ? L - 1 : ck);
            const bf16_t* kp = ka + (size_t)(b * SEQ + ck * d + rho) * 1536 + hoff + 8 * g;
            kf[2 * kt] = *(const bf16x8*)kp; kf[2 * kt + 1] = *(const bf16x8*)(kp + 32);
        }
    };
    bf16x8 kn[4];
    load_k(0, kn); issue_v(0, 0);
    for (int chunk = 0; chunk < nchunks; ++chunk) {
        asm volatile("s_waitcnt vmcnt(0)" ::: "memory");
        bf16x8 kc[4];
#pragma unroll
        for (int i = 0; i < 4; ++i) kc[i] = kn[i];
        if (chunk + 1 < nchunks) { load_k(chunk + 1, kn); issue_v(chunk + 1, (chunk + 1) & 1); }
        LAS unsigned char* vb = vbuf + (chunk & 1) * 4096;
        bf16x8 vf[4];
#pragma unroll
        for (int n = 0; n < 4; ++n) {
            const v4i16_t lo = __builtin_amdgcn_ds_read_tr16_b64_v4i16((LAS v4i16_t*)(vb + voff0[n]));
            const v4i16_t hi = __builtin_amdgcn_ds_read_tr16_b64_v4i16((LAS v4i16_t*)(vb + voff1[n]));
            vf[n] = (bf16x8){lo[0], lo[1], lo[2], lo[3], hi[0], hi[1], hi[2], hi[3]};
        }
#pragma unroll
        for (int t = 0; t < NT; ++t) {
            f32x4 sA = {0.f, 0.f, 0.f, 0.f}, sB = {0.f, 0.f, 0.f, 0.f};
            sA = __builtin_amdgcn_mfma_f32_16x16x32_bf16(kc[0], qf[t][0], sA, 0, 0, 0);
            sA = __builtin_amdgcn_mfma_f32_16x16x32_bf16(kc[1], qf[t][1], sA, 0, 0, 0);
            sB = __builtin_amdgcn_mfma_f32_16x16x32_bf16(kc[2], qf[t][0], sB, 0, 0, 0);
            sB = __builtin_amdgcn_mfma_f32_16x16x32_bf16(kc[3], qf[t][1], sB, 0, 0, 0);
            const int jc = jl[t] - 32 * chunk;
            float s[8]; float cm = -1e30f;
#pragma unroll
            for (int e = 0; e < 8; ++e) {
                const int j = jc - ((e & 3) + 16 * (e >> 2));
                const float v = ((e < 4) ? sA[e & 3] : sB[e & 3]) - bslope * (float)j;
                s[e] = ((unsigned)j <= (unsigned)jmax[t]) ? v : -1e30f;
                cm = fmaxf(cm, s[e]);
            }
            cm = fmaxf(cm, __shfl_xor(cm, 16)); cm = fmaxf(cm, __shfl_xor(cm, 32));
            const float mn = fmaxf(m[t], cm);
            const float alpha = __builtin_amdgcn_exp2f(m[t] - mn);
            m[t] = mn;
            float p[8]; float ps = 0.f;
#pragma unroll
            for (int e = 0; e < 8; ++e) { p[e] = (s[e] > -1e29f) ? __builtin_amdgcn_exp2f(s[e] - mn) : 0.f; ps += p[e]; }
            l[t] = l[t] * alpha + ps;
            u32x4 pw; pw.x = cvtpk_bf16(p[0], p[1]); pw.y = cvtpk_bf16(p[2], p[3]); pw.z = cvtpk_bf16(p[4], p[5]); pw.w = cvtpk_bf16(p[6], p[7]);
            const bf16x8 pf = __builtin_bit_cast(bf16x8, pw);
#pragma unroll
            for (int n = 0; n < 4; ++n) {
                f32x4 ov = o[t * 4 + n];
                ov = ov * alpha;
                o[t * 4 + n] = __builtin_amdgcn_mfma_f32_16x16x32_bf16(vf[n], pf, ov, 0, 0, 0);
            }
        }
    }
}
__device__ __forceinline__ void ph_attn(const bf16_t* __restrict__ qa, const bf16_t* __restrict__ ka, const bf16_t* __restrict__ va, bf16_t* __restrict__ oattn, LAS unsigned char* lds) {
    const int tid_ = fresh_tid(); const int lane = tid_ & 63, w = __builtin_amdgcn_readfirstlane(tid_ >> 6);
    LAS unsigned char* vbuf = lds + w * 8192;
    const float LOG2E = 1.4426950408889634f;
    for (int unit = blockIdx.x; unit < 512; unit += gridDim.x) {
        const int b = unit >> 7, h = unit & 7, t0 = ((unit >> 3) & 15) * 256;
        const float slope = exp2f(-(float)(h + 1)) * LOG2E;
        f32x4 o[8]; float m[2] = {-1e30f, -1e30f}, l[2] = {0.f, 0.f};
#pragma unroll
        for (int i = 0; i < 8; ++i) o[i] = (f32x4){0.f, 0.f, 0.f, 0.f};
        {
            const int cq0[2] = {t0 + w, t0 + w + 8};
            attn_group<2>(qa, ka, va, b, h, 0, 1, 0, 4096, cq0, 16, t0 + w - 128, 12, slope, o, m, l, vbuf, lane);
        }
        {
            const int rho = w & 3, cA = (t0 + w - rho) >> 2;
            const int cq0[2] = {cA, cA + 2};
            attn_group<2>(qa, ka, va, b, h, 1, 4, rho, 1024, cq0, 4, cA - 128, 6, slope * 4.0f, o, m, l, vbuf, lane);
        }
        {
            const int cq0[1] = {t0 >> 4};
            attn_group<1>(qa, ka, va, b, h, 2, 16, w, 256, cq0, 1, (t0 >> 4) - 128, 5, slope * 16.0f, o, m, l, vbuf, lane);
            attn_group<1>(qa, ka, va, b, h, 2, 16, w + 8, 256, cq0, 1, (t0 >> 4) - 128, 5, slope * 16.0f, o + 4, m + 1, l + 1, vbuf, lane);
        }
        const int c = lane & 15, g = lane >> 4;
#pragma unroll
        for (int t = 0; t < 2; ++t) {
            float lt = l[t]; lt += __shfl_xor(lt, 16); lt += __shfl_xor(lt, 32);
            const float inv = 1.0f / lt;
            const int tok = t0 + w + 8 * t + 16 * c;
            bf16_t* op = oattn + (size_t)(b * SEQ + tok) * 512 + h * 64 + 4 * g;
#pragma unroll
            for (int n = 0; n < 4; ++n) {
                const f32x4 v = o[t * 4 + n] * inv;
                uint2 pk; pk.x = pk2(v[0], v[1]); pk.y = pk2(v[2], v[3]);
                *(uint2*)(op + 16 * n) = pk;
            }
        }
    }
}


typedef unsigned u32x2 __attribute__((ext_vector_type(2)));
__device__ __forceinline__ int trx(int row) { return ((row & 3) | (((row >> 3) & 1) << 2)) << 1; }
template <int ROWB>
__device__ __forceinline__ void dma_tile128(const bf16_t* gsrc, size_t gstride, LAS unsigned char* dst, int wid, int lane) {
    constexpr int CPR = ROWB / 16, RPI = 64 / CPR, NI = 128 / RPI;
    for (int ii = wid; ii < NI; ii += 8) {
        const int row = ii * RPI + lane / CPR, cp = lane % CPR, ch = cp ^ trx(row);
        const bf16_t* src = gsrc + (size_t)row * gstride + ch * 8;
        __builtin_amdgcn_global_load_lds((const unsigned*)src, (LAS unsigned*)(dst + ii * 1024), 16, 0, 0);
    }
}
template <int ROWB>
__device__ __forceinline__ bf16x8 tr_frag(LAS unsigned char* img, int ks, int n, int lane) {
    const int g = lane >> 4, q = (lane & 15) >> 2, p = lane & 3;
    const int r0 = 32 * ks + 8 * g + q, r1 = r0 + 4;
    const v4i16_t lo = __builtin_amdgcn_ds_read_tr16_b64_v4i16((LAS v4i16_t*)(img + r0 * ROWB + (((2 * n + (p >> 1)) ^ trx(r0)) << 4) + 8 * (p & 1)));
    const v4i16_t hi = __builtin_amdgcn_ds_read_tr16_b64_v4i16((LAS v4i16_t*)(img + r1 * ROWB + (((2 * n + (p >> 1)) ^ trx(r1)) << 4) + 8 * (p & 1)));
    return (bf16x8){lo[0], lo[1], lo[2], lo[3], hi[0], hi[1], hi[2], hi[3]};
}
template <int ROWB>
__device__ __forceinline__ int tr_base(int n, int lane) {
    const int g = lane >> 4, q = (lane & 15) >> 2, p = lane & 3;
    return (8 * g + q) * ROWB + ((n ^ (q | ((g & 1) << 2))) << 5) + ((p >> 1) << 4) + 8 * (p & 1);
}
template <int ROWB>
__device__ __forceinline__ bf16x8 tr_frag_at(LAS unsigned char* img, int base, int ks) {
    const v4i16_t lo = __builtin_amdgcn_ds_read_tr16_b64_v4i16((LAS v4i16_t*)(img + base + ks * 32 * ROWB));
    const v4i16_t hi = __builtin_amdgcn_ds_read_tr16_b64_v4i16((LAS v4i16_t*)(img + base + ks * 32 * ROWB + 4 * ROWB));
    return (bf16x8){lo[0], lo[1], lo[2], lo[3], hi[0], hi[1], hi[2], hi[3]};
}
__device__ __forceinline__ float ret_log2gamma(int h) { return log2f(1.0f - exp2f(-5.0f - (float)h)); }

__device__ __forceinline__ void ph_ret_kv(const bf16_t* __restrict__ kr, const bf16_t* __restrict__ vr, bf16_t* __restrict__ KVb, LAS unsigned char* lds) {
    const int tid_ = fresh_tid(); const int lane = tid_ & 63, w = __builtin_amdgcn_readfirstlane(tid_ >> 6), c16 = lane & 15, g = lane >> 4;
    LAS unsigned char* kimg = lds; LAS unsigned char* vimg = lds + 32768;
    const float ksc = 0.08838834764831845f;
    for (int unit = blockIdx.x; unit < 512; unit += gridDim.x) {
        const int b = unit >> 7, h = (unit >> 5) & 3, c = unit & 31;
        const size_t tok0 = (size_t)b * SEQ + c * 128;
        const float lg = ret_log2gamma(h);
        __syncthreads();
        dma_tile128<256>(kr + tok0 * 512 + h * 128, 512, kimg, w, lane);
        dma_tile128<512>(vr + tok0 * 1024 + h * 256, 1024, vimg, w, lane);
        asm volatile("s_waitcnt vmcnt(0)" ::: "memory");
        __syncthreads();
        f32x4 acc[2][8];
#pragma unroll
        for (int i = 0; i < 2; ++i)
#pragma unroll
            for (int j = 0; j < 8; ++j) acc[i][j] = (f32x4){0.f, 0.f, 0.f, 0.f};
        int vb[2], kb[8];
#pragma unroll
        for (int dvt = 0; dvt < 2; ++dvt) vb[dvt] = tr_base<512>(2 * w + dvt, lane);
#pragma unroll
        for (int dkt = 0; dkt < 8; ++dkt) kb[dkt] = tr_base<256>(dkt, lane);
#pragma unroll 1
        for (int ks = 0; ks < 4; ++ks) {
            bf16x8 vf[2];
            float z[8];
#pragma unroll
            for (int j = 0; j < 8; ++j) z[j] = ksc * __builtin_amdgcn_exp2f(lg * (float)(127 - (32 * ks + 8 * g + j)));
#pragma unroll
            for (int dvt = 0; dvt < 2; ++dvt) {
                const bf16x8 raw = tr_frag_at<512>(vimg, vb[dvt], ks);
                unsigned pk[4];
#pragma unroll
                for (int j = 0; j < 8; j += 2) pk[j >> 1] = cvtpk_bf16(bf2f((bf16_t)raw[j]) * z[j], bf2f((bf16_t)raw[j + 1]) * z[j + 1]);
                vf[dvt] = __builtin_bit_cast(bf16x8, (u32x4){pk[0], pk[1], pk[2], pk[3]});
            }
#pragma unroll
            for (int dkt = 0; dkt < 8; ++dkt) {
                const bf16x8 kf = tr_frag_at<256>(kimg, kb[dkt], ks);
                acc[0][dkt] = __builtin_amdgcn_mfma_f32_16x16x32_bf16(vf[0], kf, acc[0][dkt], 0, 0, 0);
                acc[1][dkt] = __builtin_amdgcn_mfma_f32_16x16x32_bf16(vf[1], kf, acc[1][dkt], 0, 0, 0);
            }
        }
        bf16_t* outp = KVb + (size_t)unit * 32768;
#pragma unroll
        for (int dvt = 0; dvt < 2; ++dvt)
#pragma unroll
            for (int dkt = 0; dkt < 8; ++dkt)
#pragma unroll
                for (int reg = 0; reg < 4; ++reg) outp[(32 * w + 16 * dvt + 4 * g + reg) * 128 + 16 * dkt + c16] = f2bf(acc[dvt][dkt][reg]);
    }
}
__device__ __forceinline__ void ph_ret_scan(bf16_t* __restrict__ KS) {
    for (int i = blockIdx.x * NTHR + fresh_tid(); i < 16 * 8192; i += gridDim.x * NTHR) {
        const int bh = i >> 13, e4 = i & 8191, h = bh & 3;
        const float g128 = exp2f(128.0f * ret_log2gamma(h));
        f32x4 st = {0.f, 0.f, 0.f, 0.f};
        bf16_t* p = KS + (size_t)bh * 32 * 32768 + (size_t)e4 * 4;
#pragma unroll 8
        for (int c = 0; c < 32; ++c) {
            const uint2 kv = *(const uint2*)(p + (size_t)c * 32768);
            uint2 o; o.x = pk2(st[0], st[1]); o.y = pk2(st[2], st[3]);
            *(uint2*)(p + (size_t)c * 32768) = o;
            st[0] = st[0] * g128 + bflo(kv.x); st[1] = st[1] * g128 + bfhi(kv.x); st[2] = st[2] * g128 + bflo(kv.y); st[3] = st[3] * g128 + bfhi(kv.y);
        }
    }
}
__device__ __forceinline__ void ph_ret_out(const bf16_t* __restrict__ qr, const bf16_t* __restrict__ kr, const bf16_t* __restrict__ vr, const bf16_t* __restrict__ ST,
                                           const bf16_t* __restrict__ gsw, bf16_t* __restrict__ oret, LAS unsigned char* lds) {
    const int tid_ = fresh_tid(); const int lane = tid_ & 63, w = __builtin_amdgcn_readfirstlane(tid_ >> 6), c16 = lane & 15, g = lane >> 4;
    LAS unsigned char* vimg = lds; LAS unsigned char* pimg = lds + 65536; LAS float* red = (LAS float*)(lds + 98304);
    const float ksc = 0.08838834764831845f;
    for (int unit = blockIdx.x; unit < 512; unit += gridDim.x) {
        const int b = unit >> 7, h = (unit >> 5) & 3, c = unit & 31;
        const size_t tok0 = (size_t)b * SEQ + c * 128;
        const float lg = ret_log2gamma(h);
        __syncthreads();
        dma_tile128<512>(vr + tok0 * 1024 + h * 256, 1024, vimg, w, lane);
        {
            bf16x8 qf[4];
            const bf16_t* qp = qr + (tok0 + 16 * w + c16) * 512 + h * 128 + 8 * g;
#pragma unroll
            for (int ks = 0; ks < 4; ++ks) qf[ks] = *(const bf16x8*)(qp + 32 * ks);
            for (int kt = 0; kt < 8; ++kt) {
                u32x2 pw = {0u, 0u};
                if (kt <= w) {
                    const bf16_t* kp = kr + (tok0 + 16 * kt + c16) * 512 + h * 128 + 8 * g;
                    f32x4 s = {0.f, 0.f, 0.f, 0.f};
#pragma unroll
                    for (int ks = 0; ks < 4; ++ks) s = __builtin_amdgcn_mfma_f32_16x16x32_bf16(*(const bf16x8*)(kp + 32 * ks), qf[ks], s, 0, 0, 0);
                    float p[4];
#pragma unroll
                    for (int reg = 0; reg < 4; ++reg) {
                        const int dt = (16 * w + c16) - (16 * kt + 4 * g + reg);
                        p[reg] = dt >= 0 ? s[reg] * ksc * __builtin_amdgcn_exp2f(lg * (float)dt) : 0.f;
                    }
                    pw.x = cvtpk_bf16(p[0], p[1]); pw.y = cvtpk_bf16(p[2], p[3]);
                }
                *(LAS u32x2*)(pimg + (16 * w + c16) * 256 + (((2 * kt + (g >> 1)) ^ c16) << 4) + 8 * (g & 1)) = pw;
            }
        }
        asm volatile("s_waitcnt vmcnt(0)" ::: "memory");
        __syncthreads();
        f32x4 acc[2][8];
#pragma unroll
        for (int i = 0; i < 2; ++i)
#pragma unroll
            for (int j = 0; j < 8; ++j) acc[i][j] = (f32x4){0.f, 0.f, 0.f, 0.f};
        const bf16_t* stp = ST + (size_t)unit * 32768 + (size_t)(32 * w + c16) * 128 + 8 * g;
#pragma unroll
        for (int ks = 0; ks < 4; ++ks) {
            const bf16x8 sf0 = *(const bf16x8*)(stp + 32 * ks), sf1 = *(const bf16x8*)(stp + 16 * 128 + 32 * ks);
#pragma unroll
            for (int qt = 0; qt < 8; ++qt) {
                const bf16x8 qf2 = *(const bf16x8*)(qr + (tok0 + 16 * qt + c16) * 512 + h * 128 + 32 * ks + 8 * g);
                acc[0][qt] = __builtin_amdgcn_mfma_f32_16x16x32_bf16(sf0, qf2, acc[0][qt], 0, 0, 0);
                acc[1][qt] = __builtin_amdgcn_mfma_f32_16x16x32_bf16(sf1, qf2, acc[1][qt], 0, 0, 0);
            }
        }
#pragma unroll
        for (int qt = 0; qt < 8; ++qt) {
            const float xi = __builtin_amdgcn_exp2f(lg * (float)(16 * qt + c16 + 1));
            acc[0][qt] = acc[0][qt] * xi; acc[1][qt] = acc[1][qt] * xi;
        }
#pragma unroll
        for (int ks = 0; ks < 4; ++ks) {
            const bf16x8 vf0 = tr_frag_at<512>(vimg, tr_base<512>(2 * w, lane), ks), vf1 = tr_frag_at<512>(vimg, tr_base<512>(2 * w + 1, lane), ks);
#pragma unroll
            for (int qt = 2 * ks; qt < 8; ++qt) {
                const bf16x8 pf = *(LAS bf16x8*)(pimg + (16 * qt + c16) * 256 + (((4 * ks + g) ^ c16) << 4));
                acc[0][qt] = __builtin_amdgcn_mfma_f32_16x16x32_bf16(vf0, pf, acc[0][qt], 0, 0, 0);
                acc[1][qt] = __builtin_amdgcn_mfma_f32_16x16x32_bf16(vf1, pf, acc[1][qt], 0, 0, 0);
            }
        }
#pragma unroll
        for (int qt = 0; qt < 8; ++qt) {
            float s1 = 0.f, s2 = 0.f;
#pragma unroll
            for (int dvt = 0; dvt < 2; ++dvt)
#pragma unroll
                for (int reg = 0; reg < 4; ++reg) { const float v = acc[dvt][qt][reg]; s1 += v; s2 += v * v; }
            s1 += __shfl_xor(s1, 16); s1 += __shfl_xor(s1, 32);
            s2 += __shfl_xor(s2, 16); s2 += __shfl_xor(s2, 32);
            if (g == 0) { red[(w * 128 + 16 * qt + c16) * 2] = s1; red[(w * 128 + 16 * qt + c16) * 2 + 1] = s2; }
        }
        __syncthreads();
#pragma unroll
        for (int qt = 0; qt < 8; ++qt) {
            float t1 = 0.f, t2 = 0.f;
#pragma unroll
            for (int ww = 0; ww < 8; ++ww) { t1 += red[(ww * 128 + 16 * qt + c16) * 2]; t2 += red[(ww * 128 + 16 * qt + c16) * 2 + 1]; }
            const float mu = t1 * (1.0f / 256.0f);
            const float var = fmaxf(t2 * (1.0f / 256.0f) - mu * mu, 0.f);
            const float r = rsqrtf(var + 1e-6f);
            const size_t rowoff = (tok0 + 16 * qt + c16) * 1024 + h * 256 + 32 * w + 4 * g;
#pragma unroll
            for (int dvt = 0; dvt < 2; ++dvt) {
                const uint2 gs = *(const uint2*)(gsw + rowoff + 16 * dvt);
                const float g0 = bflo(gs.x), g1 = bfhi(gs.x), g2 = bflo(gs.y), g3 = bfhi(gs.y);
                const f32x4 v = acc[dvt][qt];
                uint2 o;
                o.x = pk2(g0 * sigmoidf_fast(g0) * (v[0] - mu) * r, g1 * sigmoidf_fast(g1) * (v[1] - mu) * r);
                o.y = pk2(g2 * sigmoidf_fast(g2) * (v[2] - mu) * r, g3 * sigmoidf_fast(g3) * (v[3] - mu) * r);
                *(uint2*)(oret + rowoff + 16 * dvt) = o;
            }
        }
    }
}

__device__ __forceinline__ void ph_route(const Params& p, const float* __restrict__ x1, char* route, LAS unsigned char* lds) {
    LAS float* logits = (LAS float*)lds;
    LAS int* sel_e = (LAS int*)(lds + 12288);
    LAS float* sel_w = (LAS float*)(lds + 12288 + 512);
    const int t = fresh_tid(), wid = t >> 6, lane = t & 63, c = lane & 15, q = lane >> 4;
    int* wgcnt = (int*)(route + R_WGCNT); int* tok_e = (int*)(route + R_TOKE); int* tok_rank = (int*)(route + R_TOKRANK);
    float* tok_w = (float*)(route + R_TOKW); float* rstd_o = (float*)(route + R_RSTD);
    for (int grp = blockIdx.x; grp < NTOK / 64; grp += gridDim.x) {
        const int tok0 = grp * 64;
        __syncthreads();
        {
            const int tile = wid & 3, kb = (wid >> 2) * 512;
            const int tok = tok0 + tile * 16 + c;
            f32x4 a0 = {0.f, 0.f, 0.f, 0.f}, a1 = a0, a2 = a0; float ssq = 0.f;
            const float* xr = x1 + (size_t)tok * DM + kb + 4 * q;
            LAS unsigned char* Wl = lds + 32768;
            float4 xn[8];
#pragma unroll
            for (int j = 0; j < 8; ++j) xn[j] = *(const float4*)(xr + 16 * j);
#pragma unroll 1
            for (int stage = 0; stage < 2; ++stage) {
                __syncthreads();
#pragma unroll 3
                for (int r = 0; r < 9; ++r) {
                    const int id = t + 512 * r, j = id % 9, kk = id / 9, hh = kk >> 8, kl = kk & 255, k = hh * 512 + stage * 256 + kl;
                    const float4 v = (j < 8) ? *(const float4*)(p.w_er + k * 32 + 4 * j) : *(const float4*)(p.w_gr + k * 4);
                    const float gk = p.g_ffn[k];
                    LAS float* d = (LAS float*)(Wl + hh * 49152 + (kl >> 2) * 768 + j * 64 + (kl & 3) * 4);
                    d[0] = v.x * gk; d[4] = v.y * gk; d[8] = v.z * gk; d[12] = v.w * gk;
                }
                __syncthreads();
                const LAS unsigned char* wl = Wl + (wid >> 2) * 49152 + q * 768 + c * 16;
#pragma unroll 1
                for (int h8 = 0; h8 < 2; ++h8) {
                    const int it0 = stage * 16 + h8 * 8;
#pragma unroll
                    for (int j = 0; j < 8; ++j) {
                        const float4 xa = xn[j];
                        if (it0 + 8 < 32) xn[j] = *(const float4*)(xr + 16 * (it0 + 8 + j));
                        ssq += xa.x * xa.x + xa.y * xa.y + xa.z * xa.z + xa.w * xa.w;
                        const float av[4] = {xa.x, xa.y, xa.z, xa.w};
                        const LAS unsigned char* wr = wl + (h8 * 8 + j) * 4 * 768;
                        const f32x4 w0 = *(const LAS f32x4*)(wr), w1 = *(const LAS f32x4*)(wr + 256), w2r = *(const LAS f32x4*)(wr + 512);
                        const f32x4 w2 = (c < 4) ? w2r : (f32x4){0.f, 0.f, 0.f, 0.f};
#pragma unroll
                        for (int i = 0; i < 4; ++i) {
                            a0 = __builtin_amdgcn_mfma_f32_16x16x4f32(av[i], w0[i], a0, 0, 0, 0);
                            a1 = __builtin_amdgcn_mfma_f32_16x16x4f32(av[i], w1[i], a1, 0, 0, 0);
                            a2 = __builtin_amdgcn_mfma_f32_16x16x4f32(av[i], w2[i], a2, 0, 0, 0);
                        }
                        asm volatile("" ::: "memory");
                    }
                }
            }
            ssq += __shfl_xor(ssq, 16); ssq += __shfl_xor(ssq, 32);
            LAS float* park = (LAS float*)(lds + 16384) + (tile * 64 + lane) * 13;
            if (wid >= 4) {
#pragma unroll
                for (int r = 0; r < 4; ++r) { park[r] = a0[r]; park[4 + r] = a1[r]; park[8 + r] = a2[r]; }
                park[12] = ssq;
            }
            __syncthreads();
            if (wid < 4) {
#pragma unroll
                for (int r = 0; r < 4; ++r) { a0[r] += park[r]; a1[r] += park[4 + r]; a2[r] += park[8 + r]; }
                ssq += park[12];
                const float rstd = rsqrtf(ssq * (1.0f / DM) + 1e-6f);
                if (q == 0) rstd_o[tok] = rstd;
                const float be0 = p.b_er[c], be1 = p.b_er[16 + c], bg = (c < 4) ? p.b_gr[c] : 0.f;
#pragma unroll
                for (int reg = 0; reg < 4; ++reg) {
                    const int r = 4 * q + reg;
                    const float rs = __shfl(rstd, r);
                    LAS float* lp = logits + (tile * 16 + r) * 48;
                    lp[c] = a0[reg] * rs + be0; lp[16 + c] = a1[reg] * rs + be1;
                    if (c < 4) lp[32 + c] = a2[reg] * rs + bg;
                }
            }
        }
        __syncthreads();
        if (t < 64) {
            const LAS float* lp = logits + t * 48;
            int gi = 0; float mx = lp[32];
            for (int j = 1; j < 4; ++j) if (lp[32 + j] > mx) { mx = lp[32 + j]; gi = j; }
            float sum = 0.f;
            for (int j = 0; j < 4; ++j) sum += __expf(lp[32 + j] - mx);
            const float gval = 1.0f / sum;
            const LAS float* el = lp + gi * 8;
            int i1 = 0; float v1 = el[0];
            for (int j = 1; j < 8; ++j) if (el[j] > v1) { v1 = el[j]; i1 = j; }
            int i2 = 0; float v2 = -3.0e38f;
            for (int j = 0; j < 8; ++j) if (j != i1 && el[j] > v2) { v2 = el[j]; i2 = j; }
            const float e2 = __expf(v2 - v1);
            sel_e[2 * t] = gi * 8 + i1; sel_e[2 * t + 1] = gi * 8 + i2;
            sel_w[2 * t] = gval / (1.0f + e2); sel_w[2 * t + 1] = gval * e2 / (1.0f + e2);
        }
        __syncthreads();
        if (t < 128) {
            const int e = sel_e[t]; int rank = 0;
            for (int j = 0; j < t; ++j) rank += (sel_e[j] == e) ? 1 : 0;
            tok_e[tok0 * 2 + t] = e; tok_rank[tok0 * 2 + t] = rank; tok_w[tok0 * 2 + t] = sel_w[t];
        } else if (t < 160) {
            const int e = t - 128; int cnt = 0;
            for (int j = 0; j < 128; ++j) cnt += (sel_e[j] == e) ? 1 : 0;
            wgcnt[grp * 32 + e] = cnt;
        }
    }
}
__device__ __forceinline__ void moe_tables(const char* route, LAS unsigned char* lds, int grp) {
    LAS int* tstart = (LAS int*)(lds + LDS_MOE); LAS int* tot = tstart + 64; LAS int* bef = tstart + 128; LAS int* part = (LAS int*)(lds + 16384);
    const int* wgcnt = (const int*)(route + R_WGCNT);
    const int t = fresh_tid(), e = t & 31, pt = t >> 5;
    int s = 0, sb = 0;
#pragma unroll
    for (int j = 0; j < 16; ++j) { const int g = pt * 16 + j; const int v = wgcnt[g * 32 + e]; s += v; sb += (g < grp) ? v : 0; }
    part[pt * 32 + e] = s; part[512 + pt * 32 + e] = sb;
    __syncthreads();
    if (t < 32) { int a = 0, b = 0; for (int j = 0; j < 16; ++j) { a += part[j * 32 + t]; b += part[512 + j * 32 + t]; } tot[t] = a; bef[t] = b; }
    __syncthreads();
    if (t == 0) { int acc = 0; for (int k = 0; k < 32; ++k) { tstart[k] = acc; acc += (tot[k] + 255) >> 8; } tstart[32] = acc; }
    __syncthreads();
}
__device__ __forceinline__ void ph_gather(const Params& p, const float* __restrict__ x1, char* route, bf16_t* xs, LAS unsigned char* lds) {
    LAS int* tstart = (LAS int*)(lds + LDS_MOE); LAS int* bef = tstart + 128;
    const int* wgcnt = (const int*)(route + R_WGCNT); const int* tok_e = (const int*)(route + R_TOKE); const int* tok_rank = (const int*)(route + R_TOKRANK);
    const float* tok_w = (const float*)(route + R_TOKW); const float* rstd_i = (const float*)(route + R_RSTD);
    int* slot_tok = (int*)(route + R_SLOTTOK); float* slot_w = (float*)(route + R_SLOTW);
    const int t = fresh_tid(), wid = t >> 6, lane = t & 63;
    if ((int)blockIdx.x >= NTOK / 64) moe_tables(route, lds, 0);
    for (int grp = blockIdx.x; grp < NTOK / 64; grp += gridDim.x) {
        __syncthreads();
        moe_tables(route, lds, grp);
        for (int j = wid; j < 128; j += 8) {
            const int tok = grp * 64 + (j >> 1), ch = j & 1;
            const int e = tok_e[tok * 2 + ch];
            const int slot = tstart[e] * 256 + bef[e] + tok_rank[tok * 2 + ch];
            const float rs = rstd_i[tok];
#pragma unroll
            for (int jj = 0; jj < 4; ++jj) {
                const float4 v = ((const float4*)(x1 + (size_t)tok * DM))[lane + 64 * jj];
                const float4 gg = ((const float4*)p.g_ffn)[lane + 64 * jj];
                uint2 o; o.x = pk2(v.x * rs * gg.x, v.y * rs * gg.y); o.y = pk2(v.z * rs * gg.z, v.w * rs * gg.w);
                ((uint2*)(xs + (size_t)slot * DM))[lane + 64 * jj] = o;
            }
            if (lane == 0) { slot_tok[slot] = ch * NTOK + tok; slot_w[slot] = tok_w[tok * 2 + ch]; }
        }
    }
}
struct MoeOrder {
    const LAS int* tstart; int G, c, nunits;
    __device__ __forceinline__ bool next(int i, pg8::Unit& u) const {
        const long L = (long)i * G + c; if (L >= nunits) return false;
        const int T = (int)(L >> 2), nt = (int)(L & 3); int e = 0;
        for (int j = 1; j < 32; ++j) e += (tstart[j] <= T) ? 1 : 0;
        u.pm = T; u.pn = e * 4 + nt; return true;
    }
    __device__ __forceinline__ void a_ready(const pg8::Unit&) const {}
    __device__ __forceinline__ void done(const pg8::Unit&) const {}
};
struct EpiMoe1 {
    static constexpr bool PERM = true, AFTER_DRAIN = false;
    bf16_t* hid; const float* slot_w;
    __device__ __forceinline__ void operator()(const f32x4 (&acc)[2][2][4][2], const pg8::Unit& u, int wr, int wc, int fr, int fq) const {
        const int row0 = u.pm * 256 + wr * 64 + fr, f0 = (u.pn & 3) * 128 + wc * 16 + 4 * fq;
#pragma unroll
        for (int ai = 0; ai < 2; ++ai)
#pragma unroll
            for (int m = 0; m < 4; ++m) {
                const int row = row0 + ai * 128 + m * 16;
                const float w = slot_w[row];
#pragma unroll
                for (int bj = 0; bj < 2; ++bj) {
                    const f32x4 g = acc[ai][bj][m][0], up = acc[ai][bj][m][1];
                    float o[4];
#pragma unroll
                    for (int i = 0; i < 4; ++i) o[i] = g[i] * sigmoidf_fast(g[i]) * up[i] * w;
                    uint2 pk; pk.x = pk2(o[0], o[1]); pk.y = pk2(o[2], o[3]);
                    *(uint2*)(hid + (size_t)row * 512 + f0 + bj * 64) = pk;
                }
            }
    }
};
struct EpiMoe2 {
    static constexpr bool PERM = true, AFTER_DRAIN = false;
    bf16_t* y01; const int* slot_tok; const LAS int* tstart; const LAS int* tot;
    __device__ __forceinline__ void operator()(const f32x4 (&acc)[2][2][4][2], const pg8::Unit& u, int wr, int wc, int fr, int fq) const {
        const int e = u.pn >> 2, nvalid = tot[e] - (u.pm - tstart[e]) * 256;
        const int lrow0 = wr * 64 + fr, col0 = (u.pn & 3) * 256 + wc * 32 + 8 * fq;
#pragma unroll
        for (int ai = 0; ai < 2; ++ai)
#pragma unroll
            for (int m = 0; m < 4; ++m) {
                const int lrow = lrow0 + ai * 128 + m * 16;
                if (lrow < nvalid) {
                    const int dst = slot_tok[u.pm * 256 + lrow];
                    bf16_t* rowp = y01 + (size_t)dst * 1024 + col0;
#pragma unroll
                    for (int bj = 0; bj < 2; ++bj) {
                        const f32x4 v0 = acc[ai][bj][m][0], v1 = acc[ai][bj][m][1];
                        u32x4 o; o.x = pk2(v0[0], v0[1]); o.y = pk2(v0[2], v0[3]); o.z = pk2(v1[0], v1[1]); o.w = pk2(v1[2], v1[3]);
                        *(u32x4*)(rowp + bj * 128) = o;
                    }
                }
            }
    }
};
__device__ __forceinline__ void ph_final(const float* __restrict__ x1, const bf16_t* __restrict__ y01, const float* __restrict__ g, float* __restrict__ out) {
    const int tid_ = fresh_tid(); const int lane = tid_ & 63, gw = blockIdx.x * 8 + (tid_ >> 6), ngw = gridDim.x * 8;
    for (int row = gw; row < NTOK; row += ngw) {
        float4 v[4]; float ss = 0.f;
#pragma unroll
        for (int j = 0; j < 4; ++j) {
            v[j] = ((const float4*)(x1 + (size_t)row * DM))[lane + 64 * j];
            const uint2 a = ((const uint2*)(y01 + (size_t)row * DM))[lane + 64 * j];
            const uint2 b = ((const uint2*)(y01 + (size_t)(NTOK + row) * DM))[lane + 64 * j];
            v[j].x += bflo(a.x) + bflo(b.x); v[j].y += bfhi(a.x) + bfhi(b.x); v[j].z += bflo(a.y) + bflo(b.y); v[j].w += bfhi(a.y) + bfhi(b.y);
            ss += v[j].x * v[j].x + v[j].y * v[j].y + v[j].z * v[j].z + v[j].w * v[j].w;
        }
        ss = wave_sum(ss);
        const float r = rsqrtf(ss * (1.0f / DM) + 1e-6f);
#pragma unroll
        for (int j = 0; j < 4; ++j) {
            const float4 gg = ((const float4*)g)[lane + 64 * j];
            float4 o; o.x = v[j].x * r * gg.x; o.y = v[j].y * r * gg.y; o.z = v[j].z * r * gg.z; o.w = v[j].w * r * gg.w;
            ((float4*)(out + (size_t)row * DM))[lane + 64 * j] = o;
        }
    }
}

__global__ void __launch_bounds__(NTHR, 2) fwd_megakernel(Params p) {
    extern __shared__ __attribute__((aligned(16))) unsigned char lds_raw[];
    LAS unsigned char* lds = (LAS unsigned char*)lds_raw;
    cg::grid_group grid = cg::this_grid();
    char* ws = p.ws; char* ob = p.ob;
    bf16_t* WinT = (bf16_t*)(ws + WS_WINT * MiB);
    bf16_t* PAt = (bf16_t*)(ws + WS_PAT * MiB);
    bf16_t* PRt = (bf16_t*)(ws + WS_PRT * MiB);
    bf16_t* WoT = (bf16_t*)(ws + WS_WOT * MiB);
    bf16_t* qa = (bf16_t*)(ws + WS_QA * MiB);
    bf16_t* ka = (bf16_t*)(ws + WS_KA * MiB);
    bf16_t* va = (bf16_t*)(ws + WS_VA * MiB);
    bf16_t* qr = (bf16_t*)(ws + WS_QR * MiB);
    bf16_t* kr = (bf16_t*)(ws + WS_KR * MiB);
    bf16_t* vr = (bf16_t*)(ws + WS_VR * MiB);
    bf16_t* gsw = (bf16_t*)(ws + WS_GSW * MiB);
    bf16_t* ga = (bf16_t*)(ws + WS_GA * MiB);
    bf16_t* oattn = (bf16_t*)(ws + WS_OATTN * MiB);
    bf16_t* hb = (bf16_t*)(ob + 0 * MiB);
    bf16_t* gr = (bf16_t*)(ob + 32 * MiB);
    bf16_t* oret = (bf16_t*)(ws + WS_ORET * MiB);
    bf16_t* merged = (bf16_t*)(ws + WS_MERGED * MiB);
    float* x1 = (float*)(ws + WS_X1 * MiB);
    const int G = gridDim.x;
    if (threadIdx.x < 4) ((LAS unsigned*)(lds + LDS_BARST))[threadIdx.x] = 0u;
    __syncthreads();
    XcdBarrier bar = xcd_barrier_post((unsigned*)(ws + WS_CTL * MiB), (volatile LAS unsigned*)(lds + LDS_BARST));

    char* route = ws + WS_ROUTE * MiB;
    bf16_t* WguT = (bf16_t*)(ws + WS_WGU * MiB);
    bf16_t* WdT = (bf16_t*)(ws + WS_WD * MiB);
    bf16_t* xs = (bf16_t*)(ws + WS_XS * MiB);
    bf16_t* y01 = (bf16_t*)(ws + WS_Y01 * MiB);
    bf16_t* hid = (bf16_t*)(ob);
    bf16_t* KS = (bf16_t*)(ob);
    ph_transpose_all(p.w_in, 1024, 9728, 1, WinT, lds);
    ph_transpose_all(p.w_ab, 512, 1024, 1, PAt, lds);
    ph_transpose_all(p.w_rb, 1024, 1024, 1, PRt, lds);
    ph_transpose_all(p.w_out, 1024, 1024, 1, WoT, lds);
    ph_rmsnorm_bf16(p.x, p.g_mix, hb);
    grid.sync();
    {
        pg8::Gemm g{hb, WinT, NTOK, 9728, 1024}; pg8::StaticOrder S; S.init(NTOK, 9728, G, (int)blockIdx.x);
        EpiProj E{ws, ob};
        pg8::gemm_phase<EpiProj, pg8::StaticOrder, true, true>(lds, g, S, E);
    }
    xcd_barrier(bar);
    ph_attn(qa, ka, va, oattn, lds);
    ph_ret_kv(kr, vr, KS, lds);
    xcd_barrier(bar);
    ph_ret_scan(KS);
    {
        pg8::Gemm g{oattn, PAt, NTOK, 1024, 512}; pg8::StaticOrder S; S.init(NTOK, 1024, G, (int)blockIdx.x);
        EpiGate E{ga, merged, 0};
        pg8::gemm_phase<EpiGate, pg8::StaticOrder, true, true>(lds, g, S, E);
    }
    ph_transpose_gu(p.w_gate, p.w_up, WguT, lds);
    xcd_barrier(bar);
    ph_ret_out(qr, kr, vr, KS, gsw, oret, lds);
    xcd_barrier(bar);
    {
        pg8::Gemm g{oret, PRt, NTOK, 1024, 1024}; pg8::StaticOrder S; S.init(NTOK, 1024, G, (int)blockIdx.x);
        EpiGate E{gr, merged, 1};
        pg8::gemm_phase<EpiGate, pg8::StaticOrder, true, true>(lds, g, S, E);
    }
    xcd_barrier(bar);
    {
        pg8::Gemm g{merged, WoT, NTOK, 1024, 1024}; pg8::StaticOrder S; S.init(NTOK, 1024, G, (int)blockIdx.x);
        EpiResid E{p.x, x1};
        pg8::gemm_phase<EpiResid, pg8::StaticOrder, true, true>(lds, g, S, E);
    }
    ph_transpose_all(p.w_down, 512, 1024, 32, WdT, lds);
    xcd_barrier(bar);
    ph_route(p, x1, route, lds);
    xcd_barrier(bar);
    ph_gather(p, x1, route, xs, lds);
    xcd_barrier(bar);
    const LAS int* tstart = (const LAS int*)(lds + LDS_MOE); const LAS int* tot = tstart + 64;
    {
        pg8::Gemm g{xs, WguT, 40960, 32 * 1024, 1024}; MoeOrder S{tstart, G, (int)blockIdx.x, tstart[32] * 4};
        EpiMoe1 E{hid, (const float*)(route + R_SLOTW)};
        pg8::gemm_phase<EpiMoe1, MoeOrder, true, true>(lds, g, S, E);
    }
    xcd_barrier(bar);
    {
        pg8::Gemm g{hid, WdT, 40960, 32 * 1024, 512}; MoeOrder S{tstart, G, (int)blockIdx.x, tstart[32] * 4};
        EpiMoe2 E{y01, (const int*)(route + R_SLOTTOK), tstart, tot};
        pg8::gemm_phase<EpiMoe2, MoeOrder, true, true>(lds, g, S, E);
    }
    xcd_barrier(bar);
    ph_final(x1, y01, p.g_final, p.out);
}

extern "C" void kernel_launch(void* const* d_in, const int* in_sizes, int n_in, void* d_out, int out_size, void* d_ws, size_t ws_size, hipStream_t stream) {
    static int grid_blocks = 0;
    if (!grid_blocks) {
        int dev = 0, cus = 0, per_cu = 0;
        (void)hipGetDevice(&dev);
        (void)hipDeviceGetAttribute(&cus, hipDeviceAttributeMultiprocessorCount, dev);
        (void)hipFuncSetAttribute((const void*)fwd_megakernel, hipFuncAttributeMaxDynamicSharedMemorySize, LDS_BYTES);
        (void)hipOccupancyMaxActiveBlocksPerMultiprocessor(&per_cu, (const void*)fwd_megakernel, NTHR, LDS_BYTES);
        if (per_cu > 1) per_cu = 1;
        grid_blocks = cus * per_cu;
        if (grid_blocks <= 0 || ws_size < WS_END * MiB) { fprintf(stderr, "kernel_launch: cannot launch (grid %d, ws %zu)\n", grid_blocks, ws_size); grid_blocks = -1; }
    }
    if (grid_blocks < 0) return;
    Params p{};
    p.x = (const float*)d_in[0]; p.g_mix = (const float*)d_in[1]; p.w_in = (const float*)d_in[2]; p.w_ab = (const float*)d_in[3];
    p.w_rb = (const float*)d_in[4]; p.w_out = (const float*)d_in[5]; p.g_ffn = (const float*)d_in[6]; p.w_gr = (const float*)d_in[7];
    p.b_gr = (const float*)d_in[8]; p.w_er = (const float*)d_in[9]; p.b_er = (const float*)d_in[10]; p.w_gate = (const float*)d_in[11];
    p.w_up = (const float*)d_in[12]; p.w_down = (const float*)d_in[13]; p.g_final = (const float*)d_in[14];
    p.out = (float*)d_out; p.ws = (char*)d_ws; p.ob = (char*)d_out;
    (void)hipMemsetAsync(d_ws, 0, CTL_ZERO_BYTES, stream);
    void* args[] = {&p};
    hipError_t e = hipLaunchCooperativeKernel((const void*)fwd_megakernel, dim3(grid_blocks), dim3(NTHR), args, LDS_BYTES, stream);
    if (e != hipSuccess) fprintf(stderr, "cooperative launch failed: %s (grid %d)\n", hipGetErrorString(e), grid_blocks);
}
```

```cpp
#include <hip/hip_runtime.h>
#include <hip/hip_cooperative_groups.h>
#include <stdint.h>
#include <cstdio>
namespace cg = cooperative_groups;

namespace pg8 {
#define PG8_LAS __attribute__((address_space(3)))
typedef unsigned short bf16_t;
typedef short bf16x8 __attribute__((ext_vector_type(8)));
typedef float f32x4 __attribute__((ext_vector_type(4)));
typedef unsigned u32x4 __attribute__((ext_vector_type(4)));
constexpr int BM = 256, BK = 64, HALF = 128, HTB = HALF * BK * 2  , STAGE_BYTES = 8 * HTB, NXCD = 8, WGM = 8;

__host__ __device__ __forceinline__ int lds_byte(int r, int c) { const int st = (r >> 4) * 2 + (c >> 5), rr = r & 15, cc = c & 31, ob = rr * 64 + cc * 2; return st * 1024 + (ob ^ (((ob >> 9) & 1) << 5)); }
__host__ __device__ __forceinline__ void stage_rc(int b, int& R, int& C) { const int st = b / 1024, sb = b % 1024, swz = sb ^ (((sb >> 9) & 1) << 5); R = (st >> 1) * 16 + swz / 64; C = (st & 1) * 32 + (swz % 64) / 2; }
__host__ __device__ __forceinline__ int perm32(int rho) { const int n = rho >> 4, i = rho & 15; return 8 * (i >> 2) + 4 * n + (i & 3); }

__device__ __forceinline__ int pg8_fresh_tid() { int t = threadIdx.x; asm volatile("" : "+v"(t)); return t; }
struct Unit { int pm, pn; };
struct Gemm { const bf16_t* A; const bf16_t* Bt; int M, N, K; };

struct StaticOrder {
    int nM, nN, nwg, G, c;
    __host__ __device__ void init(int M, int N, int G_, int c_) { nM = M / BM; nN = N / BM; nwg = nM * nN; G = G_; c = c_; }
    __host__ __device__ bool next(int i, Unit& u) const {
        const long L = (long)i * G + c; if (L >= nwg) return false;
        int wgid = (int)L; { const int q = nwg / NXCD, r = nwg % NXCD, xcd = wgid % NXCD, off = wgid / NXCD; wgid = (xcd < r ? xcd * (q + 1) : r * (q + 1) + (xcd - r) * q) + off; }
        const int nig = WGM * nN, gid = wgid / nig, fm = gid * WGM, gsz = (nM - fm) < WGM ? (nM - fm) : WGM;
        u.pm = fm + ((wgid % nig) % gsz); u.pn = (wgid % nig) / gsz; return true;
    }
    __device__ __forceinline__ void a_ready(const Unit&) const {}
    __device__ __forceinline__ void done(const Unit&) const {}
};

__device__ __forceinline__ unsigned cvt_pk_bf16(float lo, float hi) { unsigned r; asm volatile("v_cvt_pk_bf16_f32 %0, %1, %2" : "=v"(r) : "v"(lo), "v"(hi)); return r; }

template <class Epi, class Sched, bool ALIGN_EPI = false, bool SP2 = false>
__device__ __forceinline__ void gemm_phase(PG8_LAS unsigned char* lds, const Gemm g, const Sched& S, const Epi& E) {
    const int tid = pg8_fresh_tid(), wid = __builtin_amdgcn_readfirstlane(tid >> 6), lane = tid & 63, wr = wid >> 2, wc = wid & 3, fr = lane & 15, fq = lane >> 4;
    const int K = g.K, nt = K / BK;
    unsigned voffA[2], voffB[2];
#pragma unroll
    for (int i = 0; i < 2; ++i) { int R, C; stage_rc(tid * 16 + i * 8192, R, C); const int Rb = Epi::PERM ? ((R & ~31) + perm32(R & 31)) : R;
        voffA[i] = (unsigned)(R * K + C) * 2u; voffB[i] = (unsigned)(Rb * K + C) * 2u; }
    const size_t kstep = (size_t)(BK * 2);
    const size_t hstep = (size_t)HALF * K * 2;
    const size_t tstep = 2 * hstep;
    const unsigned ldsw = (unsigned)wid * 1024u;
    const int aoff = lds_byte(wr * 64 + fr, fq * 8), boff = lds_byte(wc * 32 + fr, fq * 8);
#define PG8_SA(b, h) (((b) * 2 + (h)) * HTB)
#define PG8_SB(b, h) ((4 + (b) * 2 + (h)) * HTB)
#define PG8_STAGE(bufoff, gbase, voff) do { _Pragma("unroll") for (int _i = 0; _i < 2; ++_i) \
        __builtin_amdgcn_global_load_lds((const unsigned*)((const char*)(gbase) + (voff)[_i]), (PG8_LAS unsigned*)(lds + (bufoff) + ldsw + _i * 8192), 16, 0, 0); } while (0)
#define PG8_LDA(dst, b, h) do { _Pragma("unroll") for (int m = 0; m < 4; ++m) _Pragma("unroll") for (int k = 0; k < 2; ++k) dst[m][k] = *(const PG8_LAS bf16x8*)(lds + PG8_SA(b, h) + aoff + m * 2048 + k * 1024); } while (0)
#define PG8_LDB(dst, b, h) do { _Pragma("unroll") for (int n = 0; n < 2; ++n) _Pragma("unroll") for (int k = 0; k < 2; ++k) dst[n][k] = *(const PG8_LAS bf16x8*)(lds + PG8_SB(b, h) + boff + n * 2048 + k * 1024); } while (0)
#define PG8_MMA(ai, bj, At, Bt) do { __builtin_amdgcn_s_setprio(1); _Pragma("unroll") for (int m = 0; m < 4; ++m) _Pragma("unroll") for (int n = 0; n < 2; ++n) _Pragma("unroll") for (int k = 0; k < 2; ++k) \
        acc[ai][bj][m][n] = __builtin_amdgcn_mfma_f32_16x16x32_bf16(Bt[n][k], At[m][k], acc[ai][bj][m][n], 0, 0, 0); __builtin_amdgcn_s_setprio(0); } while (0)
#define PG8_WAIT_V(n) asm volatile("s_waitcnt vmcnt(" #n ")" ::: "memory")
#define PG8_WAIT_L(n) asm volatile("s_waitcnt lgkmcnt(" #n ")" ::: "memory")
#define PG8_BAR __builtin_amdgcn_s_barrier()
#define PG8_SCHED __builtin_amdgcn_sched_barrier(0)
    Unit cur, nxt; int ui = 0;
    if (!S.next(0, cur)) return;
    f32x4 acc[2][2][4][2];
#pragma unroll
    for (int a = 0; a < 2; ++a)
#pragma unroll
        for (int b = 0; b < 2; ++b)
#pragma unroll
            for (int m = 0; m < 4; ++m)
#pragma unroll
                for (int n = 0; n < 2; ++n) acc[a][b][m][n] = (f32x4){0.f, 0.f, 0.f, 0.f};
    bf16x8 At[4][2], B0[2][2], B1[2][2];
    const char* cA = (const char*)g.A + (size_t)cur.pm * tstep; const char* cB = (const char*)g.Bt + (size_t)cur.pn * tstep;
    S.a_ready(cur);
    if constexpr (SP2) {
        PG8_STAGE(PG8_SB(0, 0), cB, voffB); PG8_STAGE(PG8_SB(0, 1), cB + hstep, voffB); PG8_STAGE(PG8_SA(0, 0), cA, voffA); PG8_STAGE(PG8_SA(0, 1), cA + hstep, voffA);
        if (wr == 1) PG8_BAR;
        PG8_WAIT_V(2); PG8_BAR;
        PG8_STAGE(PG8_SB(1, 0), cB + kstep, voffB); PG8_STAGE(PG8_SA(1, 0), cA + kstep, voffA); PG8_STAGE(PG8_SB(1, 1), cB + hstep + kstep, voffB);
        PG8_WAIT_V(6); PG8_BAR;
    } else {
        PG8_STAGE(PG8_SB(0, 0), cB, voffB); PG8_STAGE(PG8_SA(0, 0), cA, voffA); PG8_STAGE(PG8_SB(0, 1), cB + hstep, voffB); PG8_STAGE(PG8_SA(0, 1), cA + hstep, voffA);
        if (wr == 1) PG8_BAR;
        PG8_WAIT_V(4); PG8_BAR;
        PG8_STAGE(PG8_SB(1, 0), cB + kstep, voffB); PG8_STAGE(PG8_SA(1, 0), cA + kstep, voffA); PG8_STAGE(PG8_SB(1, 1), cB + hstep + kstep, voffB);
        PG8_WAIT_V(6); PG8_BAR;
    }
    for (;;) {
        const bool has_next = S.next(ui + 1, nxt);
        const char* nA = has_next ? (const char*)g.A + (size_t)nxt.pm * tstep : cA; const char* nB = has_next ? (const char*)g.Bt + (size_t)nxt.pn * tstep : cB;
        for (int t = 0; t < nt; t += 2) {
            const bool last = (t == nt - 2);
            const char* a1 = cA + (size_t)(t + 1) * kstep;
            const char* a2 = last ? nA : cA + (size_t)(t + 2) * kstep; const char* b2 = last ? nB : cB + (size_t)(t + 2) * kstep;
            const char* a3 = a2 + kstep; const char* b3 = b2 + kstep;
            if (last && has_next) S.a_ready(nxt);
            if constexpr (SP2) {
            PG8_LDB(B0, 0, 0); PG8_LDB(B1, 0, 1); PG8_SCHED; PG8_LDA(At, 0, 0); PG8_STAGE(PG8_SA(1, 1), a1 + hstep, voffA);
            PG8_WAIT_V(8); PG8_WAIT_L(0); PG8_BAR; PG8_MMA(0, 0, At, B0); PG8_MMA(0, 1, At, B1); PG8_BAR; PG8_SCHED;
            PG8_LDA(At, 0, 1); PG8_STAGE(PG8_SB(0, 0), b2, voffB); PG8_STAGE(PG8_SB(0, 1), b2 + hstep, voffB); PG8_STAGE(PG8_SA(0, 0), a2, voffA);
            PG8_WAIT_V(8); PG8_WAIT_L(0); PG8_BAR; PG8_MMA(1, 0, At, B0); PG8_MMA(1, 1, At, B1); PG8_BAR; PG8_SCHED;
            PG8_LDB(B0, 1, 0); PG8_LDB(B1, 1, 1); PG8_SCHED; PG8_LDA(At, 1, 0); PG8_STAGE(PG8_SA(0, 1), a2 + hstep, voffA);
            PG8_WAIT_V(8); PG8_WAIT_L(0); PG8_BAR; PG8_MMA(0, 0, At, B0); PG8_MMA(0, 1, At, B1); PG8_BAR; PG8_SCHED;
            PG8_LDA(At, 1, 1); PG8_STAGE(PG8_SB(1, 0), b3, voffB); PG8_STAGE(PG8_SB(1, 1), b3 + hstep, voffB); PG8_STAGE(PG8_SA(1, 0), a3, voffA);
            PG8_WAIT_V(8); PG8_WAIT_L(0); PG8_BAR; PG8_MMA(1, 0, At, B0); PG8_MMA(1, 1, At, B1); PG8_BAR; PG8_SCHED;
            } else {
            PG8_LDB(B0, 0, 0); PG8_SCHED; PG8_LDA(At, 0, 0); PG8_STAGE(PG8_SA(1, 1), a1 + hstep, voffA);
            PG8_WAIT_L(8); PG8_BAR; PG8_WAIT_L(0); PG8_MMA(0, 0, At, B0); PG8_BAR; PG8_SCHED;
            PG8_LDB(B1, 0, 1); PG8_STAGE(PG8_SB(0, 0), b2, voffB);
            PG8_BAR; PG8_WAIT_L(0); PG8_MMA(0, 1, At, B1); PG8_BAR;
            PG8_LDA(At, 0, 1); PG8_STAGE(PG8_SA(0, 0), a2, voffA);
            PG8_BAR; PG8_WAIT_L(0); PG8_MMA(1, 0, At, B0); PG8_BAR; PG8_SCHED;
            PG8_STAGE(PG8_SB(0, 1), b2 + hstep, voffB);
            PG8_WAIT_V(6); PG8_BAR; PG8_MMA(1, 1, At, B1); PG8_BAR;
            PG8_LDB(B0, 1, 0); PG8_SCHED; PG8_LDA(At, 1, 0); PG8_STAGE(PG8_SA(0, 1), a2 + hstep, voffA);
            PG8_WAIT_L(8); PG8_BAR; PG8_WAIT_L(0); PG8_MMA(0, 0, At, B0); PG8_BAR; PG8_SCHED;
            PG8_LDB(B1, 1, 1); PG8_STAGE(PG8_SB(1, 0), b3, voffB);
            PG8_BAR; PG8_WAIT_L(0); PG8_MMA(0, 1, At, B1); PG8_BAR;
            PG8_LDA(At, 1, 1); PG8_STAGE(PG8_SA(1, 0), a3, voffA);
            PG8_BAR; PG8_WAIT_L(0); PG8_MMA(1, 0, At, B0); PG8_BAR; PG8_SCHED;
            PG8_STAGE(PG8_SB(1, 1), b3 + hstep, voffB);
            PG8_WAIT_V(6); PG8_BAR; PG8_MMA(1, 1, At, B1); PG8_BAR;
            }
        }
        if constexpr (ALIGN_EPI) { if (wr == 0) PG8_BAR; }
        if constexpr (!Epi::AFTER_DRAIN) { E(acc, cur, wr, wc, fr, fq); S.done(cur); }
        if (!has_next) break;
#pragma unroll
        for (int a = 0; a < 2; ++a)
#pragma unroll
            for (int b = 0; b < 2; ++b)
#pragma unroll
                for (int m = 0; m < 4; ++m)
#pragma unroll
                    for (int n = 0; n < 2; ++n) acc[a][b][m][n] = (f32x4){0.f, 0.f, 0.f, 0.f};
        cur = nxt; cA = nA; cB = nB; ++ui;
        if constexpr (ALIGN_EPI) { if (wr == 1) PG8_BAR; }
    }
    PG8_WAIT_V(0);
    if constexpr (!ALIGN_EPI) { if (wr == 0) PG8_BAR; }
    PG8_BAR;
    if constexpr (Epi::AFTER_DRAIN) { E.fused(acc, cur, wr, wc, fr, fq, lds, wid, lane); S.done(cur); }
#undef PG8_SA
#undef PG8_SB
#undef PG8_STAGE
#undef PG8_LDA
#undef PG8_LDB
#undef PG8_MMA
#undef PG8_WAIT_V
#undef PG8_WAIT_L
#undef PG8_BAR
#undef PG8_SCHED
}
}


using pg8::bf16_t;
using pg8::bf16x8;
using pg8::f32x4;
using pg8::u32x4;
#define LAS __attribute__((address_space(3)))
#define GAS __attribute__((address_space(1)))
typedef unsigned v4u __attribute__((ext_vector_type(4)));

#define NTOK 16384
#define SEQ 4096
#define DM 1024
#define NTHR 512
#define LDS_BYTES 147456
constexpr size_t MiB = (size_t)1 << 20;
constexpr size_t WS_CTL = 0, WS_WINT = 1, WS_PAT = 20, WS_PRT = 21, WS_WOT = 23;
constexpr size_t WS_KA = 26, WS_VA = 74, WS_QR = 122, WS_KR = 138, WS_VR = 154, WS_QA = 186, WS_GSW = 234, WS_GA = 266, WS_END = 298;
constexpr size_t WS_OATTN = 1;
constexpr size_t WS_ORET = 90;
constexpr size_t WS_X1 = 122;
constexpr size_t WS_MERGED = 186;
constexpr size_t WS_ROUTE = 17;
constexpr size_t WS_WGU = 26, WS_WD = 90;
constexpr size_t WS_XS = 186;
constexpr size_t WS_Y01 = 186;
constexpr size_t R_WGCNT = 0, R_TOKE = 65536, R_TOKRANK = 196608, R_TOKW = 327680, R_RSTD = 458752, R_SLOTTOK = 524288, R_SLOTW = 720896;
constexpr int LDS_BARST = 131072 + 2048;
constexpr size_t CTL_ZERO_BYTES = 65536;
constexpr int LDS_MOE = 131072;

__device__ __forceinline__ bf16_t f2bf(float f) { unsigned u = __float_as_uint(f); return (bf16_t)((u + 0x7fffu + ((u >> 16) & 1u)) >> 16); }
__device__ __forceinline__ unsigned pk2(float lo, float hi) { return (unsigned)f2bf(lo) | ((unsigned)f2bf(hi) << 16); }
__device__ __forceinline__ float bf2f(bf16_t h) { return __uint_as_float(((unsigned)h) << 16); }
__device__ __forceinline__ float bflo(unsigned w) { return __uint_as_float(w << 16); }
__device__ __forceinline__ float bfhi(unsigned w) { return __uint_as_float(w & 0xffff0000u); }
__device__ __forceinline__ float wave_sum(float v) {
#pragma unroll
    for (int o = 32; o >= 1; o >>= 1) v += __shfl_xor(v, o);
    return v;
}
__device__ __forceinline__ float sigmoidf_fast(float g) { return __builtin_amdgcn_rcpf(1.0f + __expf(-g)); }
#define LDS_WAIT() asm volatile("s_waitcnt lgkmcnt(0)" ::: "memory")
__device__ __forceinline__ int fresh_tid() { int t = threadIdx.x; asm volatile("" : "+v"(t)); return t; }

#define XB_TMO      128
#define XB_XCNT(j)  (256  + 64 * (j))
#define XB_XSUB(j)  (1280 + 64 * (j))
#define XB_XGEN(j)  (2304 + 64 * (j))
#define XB_TOP      3328
#define XB_TOPGEN   3392
#define XCD_BAR_WORDS 3456
#define XB_SPIN_CAP (1u << 18)

__device__ __forceinline__ unsigned xb_ld(unsigned* p)              { return __hip_atomic_load(p, __ATOMIC_RELAXED, __HIP_MEMORY_SCOPE_AGENT); }
__device__ __forceinline__ unsigned xb_add(unsigned* p, unsigned v) { return __hip_atomic_fetch_add(p, v, __ATOMIC_RELAXED, __HIP_MEMORY_SCOPE_AGENT); }
__device__ __forceinline__ unsigned xb_xcc_id() { return (unsigned)__builtin_amdgcn_s_getreg((3 << 11) | 20) & 0xFu; }
#define XB_SPIN(cond, bar) do { unsigned _sp = 0; while (cond) { __builtin_amdgcn_s_sleep(1); \
    if ((++_sp & 255u) == 0u) { if (xb_ld(&(bar)[XB_TMO])) break; if (_sp > XB_SPIN_CAP) { atomicAdd(&(bar)[XB_TMO], 1u); break; } } } } while (0)

struct XcdBarrier {
    unsigned* bar; unsigned x;
    volatile LAS unsigned* st;
};

__device__ __forceinline__ XcdBarrier xcd_barrier_post(unsigned* bar, volatile LAS unsigned* st) {
    XcdBarrier b; b.bar = bar; b.x = xb_xcc_id(); b.st = st;
    if (threadIdx.x == 0) (void)xb_add(&bar[XB_XCNT(b.x)], 1u);
    return b;
}
__device__ __forceinline__ void xcd_barrier_complete(unsigned* bar, unsigned x, unsigned& nloc, unsigned& nx) {
    const unsigned G = gridDim.x * gridDim.y * gridDim.z;
    unsigned sum, cnt, mine, sp = 0u;
    for (;;) {
        sum = 0u; cnt = 0u; mine = 0u;
#pragma unroll
        for (unsigned j = 0; j < 16; ++j) { const unsigned c = xb_ld(&bar[XB_XCNT(j)]); sum += c; cnt += (c > 0u) ? 1u : 0u; mine = (j == x) ? c : mine; }
        if (sum == G) break;
        __builtin_amdgcn_s_sleep(1);
        if ((++sp & 255u) == 0u) { if (xb_ld(&bar[XB_TMO])) break; if (sp > XB_SPIN_CAP) { atomicAdd(&bar[XB_TMO], 1u); break; } }
    }
    nloc = mine > 0u ? mine : 1u; nx = cnt > 0u ? cnt : 1u;
}

__device__ __forceinline__ void xcd_barrier(const XcdBarrier& b) {
    asm volatile("s_waitcnt vmcnt(0)" ::: "memory");
    __syncthreads();
    if (threadIdx.x == 0) {
        unsigned* bar = b.bar;
        __builtin_amdgcn_s_waitcnt(0);
        unsigned nloc = b.st[0], nx = b.st[1];
        if (nloc == 0u) { xcd_barrier_complete(bar, b.x, nloc, nx); b.st[0] = nloc; b.st[1] = nx; }
        const unsigned old = xb_add(&bar[XB_XSUB(b.x)], 1u);
        const unsigned gen = old / nloc;
        if (old + 1u == (gen + 1u) * nloc) {
            __builtin_amdgcn_fence(__ATOMIC_RELEASE, "agent");
            asm volatile("s_waitcnt vmcnt(0)" ::: "memory");
            const unsigned og = xb_add(&bar[XB_TOP], 1u);
            const unsigned tg = og / nx;
            if (og + 1u == (tg + 1u) * nx) xb_add(&bar[XB_TOPGEN], 1u);
            else XB_SPIN(xb_ld(&bar[XB_TOPGEN]) == tg, bar);
            __builtin_amdgcn_fence(__ATOMIC_ACQUIRE, "agent");
            xb_add(&bar[XB_XGEN(b.x)], 1u);
            asm volatile("s_waitcnt vmcnt(0)" ::: "memory");
        } else {
            XB_SPIN(xb_ld(&bar[XB_XGEN(b.x)]) == gen, bar);
            __builtin_amdgcn_fence(__ATOMIC_ACQUIRE, "agent");
            asm volatile("s_waitcnt vmcnt(0)" ::: "memory");
        }
    }
    __syncthreads();
}

struct Params {
    const float *x, *g_mix, *w_in, *w_ab, *w_rb, *w_out, *g_ffn, *w_gr, *b_gr, *w_er, *b_er, *w_gate, *w_up, *w_down, *g_final;
    float* out; char* ws; char* ob;
};

__device__ __forceinline__ float block_sum512(float v, float* red) {
    v = wave_sum(v);
    __syncthreads();
    if ((threadIdx.x & 63) == 0) red[threadIdx.x >> 6] = v;
    __syncthreads();
    float s = 0.f;
#pragma unroll
    for (int i = 0; i < 8; ++i) s += red[i];
    return s;
}

template <bool GU>
__device__ __forceinline__ void p0_transpose_item(const float* W, int K, int N, bf16_t* WT, int row_off, LAS float* scr, int item, int lane) {
    const int nblk = N / 32, kb = item / nblk, nb = item % nblk, k0 = 64 * kb, n0 = 32 * nb;
#pragma unroll 8
    for (int i = 0; i < 32; ++i) { const int kk = 2 * i + (lane >> 5); scr[kk * 33 + (lane & 31)] = W[(size_t)(k0 + kk) * N + n0 + (lane & 31)]; }
    LDS_WAIT(); asm volatile("" ::: "memory");
    const int c = lane & 7;
#pragma unroll
    for (int j = 0; j < 4; ++j) { const int n = (lane >> 3) + 8 * j; const LAS float* s = scr + (8 * c) * 33 + n;
        v4u o; o.x = pk2(s[0 * 33], s[1 * 33]); o.y = pk2(s[2 * 33], s[3 * 33]); o.z = pk2(s[4 * 33], s[5 * 33]); o.w = pk2(s[6 * 33], s[7 * 33]);
        const int drow = GU ? ((((n0 + n) >> 2) << 3) + ((n0 + n) & 3) + row_off) : (row_off + n0 + n);
        *(GAS v4u*)(WT + (size_t)drow * K + k0 + 8 * c) = o; }
    LDS_WAIT(); asm volatile("" ::: "memory");
}
__device__ __forceinline__ void ph_transpose_all(const float* W, int K, int N, int nmat, bf16_t* WT, LAS unsigned char* lds) {
    const int tid_ = fresh_tid(); const int wave = tid_ >> 6, lane = tid_ & 63;
    LAS float* scr = (LAS float*)(lds + wave * 16384);
    const int gw = blockIdx.x * 8 + wave, NGW = gridDim.x * 8;
    const int per = (K / 64) * (N / 32), total = per * nmat;
    for (int it = gw; it < total; it += NGW) {
        const int mi = it / per, r = it % per;
        p0_transpose_item<false>(W + (size_t)mi * K * N, K, N, WT + (size_t)mi * K * N, 0, scr, r, lane);
    }
}
__device__ __forceinline__ void ph_transpose_gu(const float* Wg, const float* Wu, bf16_t* WT, LAS unsigned char* lds) {
    const int tid_ = fresh_tid(); const int wave = tid_ >> 6, lane = tid_ & 63;
    LAS float* scr = (LAS float*)(lds + wave * 16384);
    const int gw = blockIdx.x * 8 + wave, NGW = gridDim.x * 8;
    const int per = (1024 / 64) * (512 / 32), total = per * 64;
    for (int it = gw; it < total; it += NGW) {
        const int mi = it / per, r = it % per, e = mi >> 1, up = mi & 1;
        p0_transpose_item<true>((up ? Wu : Wg) + (size_t)e * 1024 * 512, 1024, 512, WT + (size_t)e * 1024 * 1024, up * 4, scr, r, lane);
    }
}

__device__ __forceinline__ void ph_rmsnorm_bf16(const float* __restrict__ x, const float* __restrict__ g, bf16_t* __restrict__ out) {
    const int tid_ = fresh_tid(); const int lane = tid_ & 63, gw = blockIdx.x * 8 + (tid_ >> 6), ngw = gridDim.x * 8;
    for (int row = gw; row < NTOK; row += ngw) {
        float4 v[4]; float ss = 0.f;
#pragma unroll
        for (int j = 0; j < 4; ++j) { v[j] = ((const float4*)(x + (size_t)row * DM))[lane + 64 * j]; ss += v[j].x * v[j].x + v[j].y * v[j].y + v[j].z * v[j].z + v[j].w * v[j].w; }
        ss = wave_sum(ss);
        const float r = rsqrtf(ss * (1.0f / DM) + 1e-6f);
#pragma unroll
        for (int j = 0; j < 4; ++j) {
            const float4 gg = ((const float4*)g)[lane + 64 * j];
            uint2 o; o.x = pk2(v[j].x * r * gg.x, v[j].y * r * gg.y); o.y = pk2(v[j].z * r * gg.z, v[j].w * r * gg.w);
            ((uint2*)(out + (size_t)row * DM))[lane + 64 * j] = o;
        }
    }
}

struct EpiProj {
    static constexpr bool PERM = true, AFTER_DRAIN = false;
    char* ws; char* ob;
    __device__ __forceinline__ void operator()(const f32x4 (&acc)[2][2][4][2], const pg8::Unit& u, int wr, int wc, int fr, int fq) const {
        const int pn = u.pn;
        if (pn < 18) {
            const int arr = pn / 6, tt = pn - arr * 6, gi = tt >> 1, sh = 2 * gi;
            bf16_t* base = (bf16_t*)(ws + (arr == 0 ? WS_QA : (arr == 1 ? WS_KA : WS_VA)) * MiB) + (size_t)gi * (NTOK * 512);
            const float sc = (arr == 0) ? 0.18033688011112042f : 1.0f;
            const int row0 = u.pm * 256 + wr * 64 + fr, hc0 = (tt & 1) * 256 + wc * 32 + 8 * fq;
            const int b = row0 >> 12, t = row0 & 4095;
            const int h0 = hc0 >> 6, dim = hc0 & 63;
            bf16_t* dst0 = base + ((size_t)((((b * 8 + h0) << sh) + (t & ((1 << sh) - 1))) * (4096 >> sh) + (t >> sh)) << 6) + dim;
            const size_t hstride = (size_t)2 * 4096 * 64;
            const int rstride = 1024 >> sh;
#pragma unroll
            for (int ai = 0; ai < 2; ++ai)
#pragma unroll
                for (int m = 0; m < 4; ++m)
#pragma unroll
                    for (int bj = 0; bj < 2; ++bj) {
                        const f32x4 v0 = acc[ai][bj][m][0] * sc, v1 = acc[ai][bj][m][1] * sc;
                        u32x4 o; o.x = pk2(v0[0], v0[1]); o.y = pk2(v0[2], v0[3]); o.z = pk2(v1[0], v1[1]); o.w = pk2(v1[2], v1[3]);
                        *(u32x4*)(dst0 + bj * hstride + (size_t)((ai * 8 + m) * rstride)) = o;
                    }
            return;
        }
        size_t off; int w, t0;
        if (pn < 20) { off = WS_QR * MiB; w = 512; t0 = 18; }
        else if (pn < 22) { off = WS_KR * MiB; w = 512; t0 = 20; }
        else if (pn < 26) { off = WS_VR * MiB; w = 1024; t0 = 22; }
        else if (pn < 30) { off = WS_GSW * MiB; w = 1024; t0 = 26; }
        else if (pn < 34) { off = WS_GA * MiB; w = 1024; t0 = 30; }
        else { off = 32 * MiB; w = 1024; t0 = 34; }
        bf16_t* base = (bf16_t*)((pn >= 34 ? ob : ws) + off);
        const int row0 = u.pm * 256 + wr * 64 + fr, col0 = (pn - t0) * 256 + wc * 32 + 8 * fq;
#pragma unroll
        for (int ai = 0; ai < 2; ++ai)
#pragma unroll
            for (int m = 0; m < 4; ++m) {
                bf16_t* rowp = base + (size_t)(row0 + ai * 128 + m * 16) * w + col0;
#pragma unroll
                for (int bj = 0; bj < 2; ++bj) {
                    const f32x4 v0 = acc[ai][bj][m][0], v1 = acc[ai][bj][m][1];
                    u32x4 o; o.x = pk2(v0[0], v0[1]); o.y = pk2(v0[2], v0[3]); o.z = pk2(v1[0], v1[1]); o.w = pk2(v1[2], v1[3]);
                    *(u32x4*)(rowp + bj * 128) = o;
                }
            }
    }
};
struct EpiGate {
    static constexpr bool PERM = true, AFTER_DRAIN = false;
    const bf16_t* gate; bf16_t* merged; int accumulate;
    __device__ __forceinline__ void operator()(const f32x4 (&acc)[2][2][4][2], const pg8::Unit& u, int wr, int wc, int fr, int fq) const {
        const int row0 = u.pm * 256 + wr * 64 + fr, col0 = u.pn * 256 + wc * 32 + 8 * fq;
#pragma unroll
        for (int ai = 0; ai < 2; ++ai)
#pragma unroll
            for (int m = 0; m < 4; ++m)
#pragma unroll
                for (int bj = 0; bj < 2; ++bj) {
                    const size_t idx = (size_t)(row0 + ai * 128 + m * 16) * 1024 + col0 + bj * 128;
                    const u32x4 g = *(const u32x4*)(gate + idx);
                    const f32x4 v0 = acc[ai][bj][m][0], v1 = acc[ai][bj][m][1];
                    float o[8];
                    o[0] = v0[0] * sigmoidf_fast(bflo(g.x)); o[1] = v0[1] * sigmoidf_fast(bfhi(g.x));
                    o[2] = v0[2] * sigmoidf_fast(bflo(g.y)); o[3] = v0[3] * sigmoidf_fast(bfhi(g.y));
                    o[4] = v1[0] * sigmoidf_fast(bflo(g.z)); o[5] = v1[1] * sigmoidf_fast(bfhi(g.z));
                    o[6] = v1[2] * sigmoidf_fast(bflo(g.w)); o[7] = v1[3] * sigmoidf_fast(bfhi(g.w));
                    if (accumulate) {
                        const u32x4 p = *(const u32x4*)(merged + idx);
                        o[0] += bflo(p.x); o[1] += bfhi(p.x); o[2] += bflo(p.y); o[3] += bfhi(p.y);
                        o[4] += bflo(p.z); o[5] += bfhi(p.z); o[6] += bflo(p.w); o[7] += bfhi(p.w);
                    }
                    u32x4 w; w.x = pk2(o[0], o[1]); w.y = pk2(o[2], o[3]); w.z = pk2(o[4], o[5]); w.w = pk2(o[6], o[7]);
                    *(u32x4*)(merged + idx) = w;
                }
    }
};
struct EpiResid {
    static constexpr bool PERM = true, AFTER_DRAIN = false;
    const float* x; float* x1;
    __device__ __forceinline__ void operator()(const f32x4 (&acc)[2][2][4][2], const pg8::Unit& u, int wr, int wc, int fr, int fq) const {
        const int row0 = u.pm * 256 + wr * 64 + fr, col0 = u.pn * 256 + wc * 32 + 8 * fq;
#pragma unroll
        for (int ai = 0; ai < 2; ++ai)
#pragma unroll
            for (int m = 0; m < 4; ++m)
#pragma unroll
                for (int bj = 0; bj < 2; ++bj) {
                    const size_t idx = (size_t)(row0 + ai * 128 + m * 16) * 1024 + col0 + bj * 128;
                    const f32x4 a = *(const f32x4*)(x + idx), b = *(const f32x4*)(x + idx + 4);
                    *(f32x4*)(x1 + idx) = a + acc[ai][bj][m][0];
                    *(f32x4*)(x1 + idx + 4) = b + acc[ai][bj][m][1];
                }
    }
};


typedef short v4i16_t __attribute__((ext_vector_type(4)));
__device__ __forceinline__ unsigned cvtpk_bf16(float lo, float hi) {
    typedef float f32x2_t __attribute__((ext_vector_type(2))); typedef __bf16 bf16x2_t __attribute__((ext_vector_type(2)));
    f32x2_t v = {lo, hi}; bf16x2_t b = __builtin_convertvector(v, bf16x2_t); return __builtin_bit_cast(unsigned, b);
}
template <int NT>
__device__ __forceinline__ void attn_group(const bf16_t* __restrict__ qa, const bf16_t* __restrict__ ka, const bf16_t* __restrict__ va,
                                           int b, int h, int grp, int d, int rho, int L, const int* cq0, int cqstep, int ck_start, int nchunks, float bslope,
                                           f32x4* o  , float* m  , float* l  , LAS unsigned char* vbuf, int lane) {
    const int c = lane & 15, g = lane >> 4;
    const int shd = 2 * grp;
    const size_t cbase = (size_t)grp * (NTOK * 512) + ((size_t)((((b * 8 + h) << shd) + rho) * L) << 6);
    bf16x8 qf[NT][2]; int jl[NT], jmax[NT];
#pragma unroll
    for (int t = 0; t < NT; ++t) {
        const int cq = cq0[t] + cqstep * c;
        const bf16_t* qp = qa + cbase + (size_t)cq * 64 + 8 * g;
        qf[t][0] = *(const bf16x8*)qp; qf[t][1] = *(const bf16x8*)(qp + 32);
        jl[t] = cq - ck_start - 4 * g; jmax[t] = cq < 128 ? cq : 128;
    }
    const int tq = c >> 2, tp = c & 3;
    const int vr0 = 4 * g + tq, vr1 = 16 + 4 * g + tq;
    const int vx0 = ((vr0 >> 1) & 3) << 1, vx1 = ((vr1 >> 1) & 3) << 1;
    int voff0[4], voff1[4];
#pragma unroll
    for (int n = 0; n < 4; ++n) {
        voff0[n] = vr0 * 128 + (((2 * n + (tp >> 1)) ^ vx0) << 4) + 8 * (tp & 1);
        voff1[n] = vr1 * 128 + (((2 * n + (tp >> 1)) ^ vx1) << 4) + 8 * (tp & 1);
    }
    const int dr = lane >> 3, dcp = lane & 7;
    auto issue_v = [&](int chunk, int buf) {
#pragma unroll
        for (int ii = 0; ii < 4; ++ii) {
            const int r = 8 * ii + dr;
            int ck = ck_start + 32 * chunk + r; ck = ck < 0 ? 0 : (ck > L - 1 ? L - 1 : ck);
            const int ch = dcp ^ (((r >> 1) & 3) << 1);
            const bf16_t* src = va + cbase + (size_t)ck * 64 + ch * 8;
            __builtin_amdgcn_global_load_lds((const unsigned*)src, (LAS unsigned*)(vbuf + buf * 4096 + ii * 1024), 16, 0, 0);
        }
    };
    auto load_k = [&](int chunk, bf16x8* kf) {
#pragma unroll
        for (int kt = 0; kt < 2; ++kt) {
            int ck = ck_start + 32 * chunk + 16 * kt + c; ck = ck < 0 ? 0 : (ck > L - 1 ? L - 1 : ck);
            const bf16_t* kp = ka + cbase + (size_t)ck * 64 + 8 * g;
            kf[2 * kt] = *(const bf16x8*)kp; kf[2 * kt + 1] = *(const bf16x8*)(kp + 32);
        }
    };
    bf16x8 kn[4];
    load_k(0, kn); issue_v(0, 0);
#pragma unroll 1
    for (int chunk = 0; chunk < nchunks; ++chunk) {
        asm volatile("s_waitcnt vmcnt(0)" ::: "memory");
        bf16x8 kc[4];
#pragma unroll
        for (int i = 0; i < 4; ++i) kc[i] = kn[i];
        if (chunk + 1 < nchunks) { load_k(chunk + 1, kn); issue_v(chunk + 1, (chunk + 1) & 1); }
        LAS unsigned char* vb = vbuf + (chunk & 1) * 4096;
        bf16x8 vf[4];
#pragma unroll
        for (int n = 0; n < 4; ++n) {
            const v4i16_t lo = __builtin_amdgcn_ds_read_tr16_b64_v4i16((LAS v4i16_t*)(vb + voff0[n]));
            const v4i16_t hi = __builtin_amdgcn_ds_read_tr16_b64_v4i16((LAS v4i16_t*)(vb + voff1[n]));
            vf[n] = (bf16x8){lo[0], lo[1], lo[2], lo[3], hi[0], hi[1], hi[2], hi[3]};
        }
#pragma unroll
        for (int t = 0; t < NT; ++t) {
            const int jc = jl[t] - 32 * chunk;
            const float cb = -bslope * (float)jc - m[t];
            f32x4 sA, sB;
#pragma unroll
            for (int e = 0; e < 4; ++e) {
                sA[e] = ((unsigned)(jc - e) <= (unsigned)jmax[t]) ? (cb + bslope * (float)e) : -1e30f;
                sB[e] = ((unsigned)(jc - 16 - e) <= (unsigned)jmax[t]) ? (cb + bslope * (float)(16 + e)) : -1e30f;
            }
            sA = __builtin_amdgcn_mfma_f32_16x16x32_bf16(kc[0], qf[t][0], sA, 0, 0, 0);
            sA = __builtin_amdgcn_mfma_f32_16x16x32_bf16(kc[1], qf[t][1], sA, 0, 0, 0);
            sB = __builtin_amdgcn_mfma_f32_16x16x32_bf16(kc[2], qf[t][0], sB, 0, 0, 0);
            sB = __builtin_amdgcn_mfma_f32_16x16x32_bf16(kc[3], qf[t][1], sB, 0, 0, 0);
            float lm = fmaxf(fmaxf(fmaxf(sA[0], sA[1]), fmaxf(sA[2], sA[3])), fmaxf(fmaxf(sB[0], sB[1]), fmaxf(sB[2], sB[3])));
            if (__any(lm > 8.0f)) {
                float cm = fmaxf(lm, __shfl_xor(lm, 16)); cm = fmaxf(cm, __shfl_xor(cm, 32));
                const float dlt = fmaxf(cm, 0.f);
                const float alpha = __builtin_amdgcn_exp2f(-dlt);
                m[t] += dlt; l[t] *= alpha;
#pragma unroll
                for (int n = 0; n < 4; ++n) o[t * 4 + n] = o[t * 4 + n] * alpha;
                sA = sA - dlt; sB = sB - dlt;
            }
            float p[8]; float ps = 0.f;
#pragma unroll
            for (int e = 0; e < 4; ++e) { p[e] = __builtin_amdgcn_exp2f(sA[e]); p[4 + e] = __builtin_amdgcn_exp2f(sB[e]); }
#pragma unroll
            for (int e = 0; e < 8; ++e) ps += p[e];
            l[t] += ps;
            u32x4 pw; pw.x = cvtpk_bf16(p[0], p[1]); pw.y = cvtpk_bf16(p[2], p[3]); pw.z = cvtpk_bf16(p[4], p[5]); pw.w = cvtpk_bf16(p[6], p[7]);
            const bf16x8 pf = __builtin_bit_cast(bf16x8, pw);
#pragma unroll
            for (int n = 0; n < 4; ++n) o[t * 4 + n] = __builtin_amdgcn_mfma_f32_16x16x32_bf16(vf[n], pf, o[t * 4 + n], 0, 0, 0);
        }
    }
}
__device__ __forceinline__ void ph_attn(const bf16_t* __restrict__ qa, const bf16_t* __restrict__ ka, const bf16_t* __restrict__ va, bf16_t* __restrict__ oattn, LAS unsigned char* lds) {
    const int tid_ = fresh_tid(); const int lane = tid_ & 63, w = __builtin_amdgcn_readfirstlane(tid_ >> 6);
    LAS unsigned char* vbuf = lds + w * 8192;
    const float LOG2E = 1.4426950408889634f;
    for (int unit = blockIdx.x; unit < 512; unit += gridDim.x) {
        const int b = unit >> 7, h = unit & 7, t0 = ((unit >> 3) & 15) * 256;
        const float slope = exp2f(-(float)(h + 1)) * LOG2E;
        f32x4 o[8]; float m[2] = {0.f, 0.f}, l[2] = {0.f, 0.f};
#pragma unroll
        for (int i = 0; i < 8; ++i) o[i] = (f32x4){0.f, 0.f, 0.f, 0.f};
        {
            const int cq0[2] = {t0 + w, t0 + w + 8};
            attn_group<2>(qa, ka, va, b, h, 0, 1, 0, 4096, cq0, 16, t0 + w - 128, 12, slope, o, m, l, vbuf, lane);
        }
        {
            const int rho = w & 3, cA = (t0 + w - rho) >> 2;
            const int cq0[2] = {cA, cA + 2};
            attn_group<2>(qa, ka, va, b, h, 1, 4, rho, 1024, cq0, 4, cA - 128, 6, slope * 4.0f, o, m, l, vbuf, lane);
        }
        {
            const int cq0[1] = {t0 >> 4};
            attn_group<1>(qa, ka, va, b, h, 2, 16, w, 256, cq0, 1, (t0 >> 4) - 128, 5, slope * 16.0f, o, m, l, vbuf, lane);
            attn_group<1>(qa, ka, va, b, h, 2, 16, w + 8, 256, cq0, 1, (t0 >> 4) - 128, 5, slope * 16.0f, o + 4, m + 1, l + 1, vbuf, lane);
        }
        const int c = lane & 15, g = lane >> 4;
#pragma unroll
        for (int t = 0; t < 2; ++t) {
            float lt = l[t]; lt += __shfl_xor(lt, 16); lt += __shfl_xor(lt, 32);
            const float inv = 1.0f / fmaxf(lt, 1e-30f);
            const int tok = t0 + w + 8 * t + 16 * c;
            bf16_t* op = oattn + (size_t)(b * SEQ + tok) * 512 + h * 64 + 4 * g;
#pragma unroll
            for (int n = 0; n < 4; ++n) {
                const f32x4 v = o[t * 4 + n] * inv;
                uint2 pk; pk.x = pk2(v[0], v[1]); pk.y = pk2(v[2], v[3]);
                *(uint2*)(op + 16 * n) = pk;
            }
        }
    }
}


typedef unsigned u32x2 __attribute__((ext_vector_type(2)));
__device__ __forceinline__ int trx(int row) { return ((row & 3) | (((row >> 3) & 1) << 2)) << 1; }
template <int ROWB>
__device__ __forceinline__ void dma_tile128(const bf16_t* gsrc, size_t gstride, LAS unsigned char* dst, int wid, int lane) {
    constexpr int CPR = ROWB / 16, RPI = 64 / CPR, NI = 128 / RPI;
    for (int ii = wid; ii < NI; ii += 8) {
        const int row = ii * RPI + lane / CPR, cp = lane % CPR, ch = cp ^ trx(row);
        const bf16_t* src = gsrc + (size_t)row * gstride + ch * 8;
        __builtin_amdgcn_global_load_lds((const unsigned*)src, (LAS unsigned*)(dst + ii * 1024), 16, 0, 0);
    }
}
template <int ROWB>
__device__ __forceinline__ bf16x8 tr_frag(LAS unsigned char* img, int ks, int n, int lane) {
    const int g = lane >> 4, q = (lane & 15) >> 2, p = lane & 3;
    const int r0 = 32 * ks + 8 * g + q, r1 = r0 + 4;
    const v4i16_t lo = __builtin_amdgcn_ds_read_tr16_b64_v4i16((LAS v4i16_t*)(img + r0 * ROWB + (((2 * n + (p >> 1)) ^ trx(r0)) << 4) + 8 * (p & 1)));
    const v4i16_t hi = __builtin_amdgcn_ds_read_tr16_b64_v4i16((LAS v4i16_t*)(img + r1 * ROWB + (((2 * n + (p >> 1)) ^ trx(r1)) << 4) + 8 * (p & 1)));
    return (bf16x8){lo[0], lo[1], lo[2], lo[3], hi[0], hi[1], hi[2], hi[3]};
}
template <int ROWB>
__device__ __forceinline__ int tr_base(int n, int lane) {
    const int g = lane >> 4, q = (lane & 15) >> 2, p = lane & 3;
    return (8 * g + q) * ROWB + ((n ^ (q | ((g & 1) << 2))) << 5) + ((p >> 1) << 4) + 8 * (p & 1);
}
template <int ROWB>
__device__ __forceinline__ bf16x8 tr_frag_at(LAS unsigned char* img, int base, int ks) {
    const v4i16_t lo = __builtin_amdgcn_ds_read_tr16_b64_v4i16((LAS v4i16_t*)(img + base + ks * 32 * ROWB));
    const v4i16_t hi = __builtin_amdgcn_ds_read_tr16_b64_v4i16((LAS v4i16_t*)(img + base + ks * 32 * ROWB + 4 * ROWB));
    return (bf16x8){lo[0], lo[1], lo[2], lo[3], hi[0], hi[1], hi[2], hi[3]};
}
__device__ __forceinline__ float ret_log2gamma(int h) { return log2f(1.0f - exp2f(-5.0f - (float)h)); }

__device__ __forceinline__ void ph_ret_kv(const bf16_t* __restrict__ kr, const bf16_t* __restrict__ vr, bf16_t* __restrict__ KVb, LAS unsigned char* lds) {
    const int tid_ = fresh_tid(); const int lane = tid_ & 63, w = __builtin_amdgcn_readfirstlane(tid_ >> 6), c16 = lane & 15, g = lane >> 4;
    LAS unsigned char* kimg = lds; LAS unsigned char* vimg = lds + 32768;
    const float ksc = 0.08838834764831845f;
    for (int unit = blockIdx.x; unit < 512; unit += gridDim.x) {
        const int b = unit >> 7, h = (unit >> 5) & 3, c = unit & 31;
        const size_t tok0 = (size_t)b * SEQ + c * 128;
        const float lg = ret_log2gamma(h);
        __syncthreads();
        dma_tile128<256>(kr + tok0 * 512 + h * 128, 512, kimg, w, lane);
        dma_tile128<512>(vr + tok0 * 1024 + h * 256, 1024, vimg, w, lane);
        asm volatile("s_waitcnt vmcnt(0)" ::: "memory");
        __syncthreads();
        f32x4 acc[2][8];
#pragma unroll
        for (int i = 0; i < 2; ++i)
#pragma unroll
            for (int j = 0; j < 8; ++j) acc[i][j] = (f32x4){0.f, 0.f, 0.f, 0.f};
        int vb[2], kb[8];
#pragma unroll
        for (int dvt = 0; dvt < 2; ++dvt) vb[dvt] = tr_base<512>(2 * w + dvt, lane);
#pragma unroll
        for (int dkt = 0; dkt < 8; ++dkt) kb[dkt] = tr_base<256>(dkt, lane);
#pragma unroll 1
        for (int ks = 0; ks < 4; ++ks) {
            bf16x8 vf[2];
            float z[8];
#pragma unroll
            for (int j = 0; j < 8; ++j) z[j] = ksc * __builtin_amdgcn_exp2f(lg * (float)(127 - (32 * ks + 8 * g + j)));
#pragma unroll
            for (int dvt = 0; dvt < 2; ++dvt) {
                const bf16x8 raw = tr_frag_at<512>(vimg, vb[dvt], ks);
                unsigned pk[4];
#pragma unroll
                for (int j = 0; j < 8; j += 2) pk[j >> 1] = cvtpk_bf16(bf2f((bf16_t)raw[j]) * z[j], bf2f((bf16_t)raw[j + 1]) * z[j + 1]);
                vf[dvt] = __builtin_bit_cast(bf16x8, (u32x4){pk[0], pk[1], pk[2], pk[3]});
            }
#pragma unroll
            for (int dkt = 0; dkt < 8; ++dkt) {
                const bf16x8 kf = tr_frag_at<256>(kimg, kb[dkt], ks);
                acc[0][dkt] = __builtin_amdgcn_mfma_f32_16x16x32_bf16(vf[0], kf, acc[0][dkt], 0, 0, 0);
                acc[1][dkt] = __builtin_amdgcn_mfma_f32_16x16x32_bf16(vf[1], kf, acc[1][dkt], 0, 0, 0);
            }
        }
        bf16_t* outp = KVb + (size_t)unit * 32768;
#pragma unroll
        for (int dvt = 0; dvt < 2; ++dvt)
#pragma unroll
            for (int dkt = 0; dkt < 8; ++dkt)
#pragma unroll
                for (int reg = 0; reg < 4; ++reg) outp[(32 * w + 16 * dvt + 4 * g + reg) * 128 + 16 * dkt + c16] = f2bf(acc[dvt][dkt][reg]);
    }
}
__device__ __forceinline__ void ph_ret_scan(bf16_t* __restrict__ KS) {
    for (int i = blockIdx.x * NTHR + fresh_tid(); i < 16 * 8192; i += gridDim.x * NTHR) {
        const int bh = i >> 13, e4 = i & 8191, h = bh & 3;
        const float g128 = exp2f(128.0f * ret_log2gamma(h));
        f32x4 st = {0.f, 0.f, 0.f, 0.f};
        bf16_t* p = KS + (size_t)bh * 32 * 32768 + (size_t)e4 * 4;
#pragma unroll 8
        for (int c = 0; c < 32; ++c) {
            const uint2 kv = *(const uint2*)(p + (size_t)c * 32768);
            uint2 o; o.x = pk2(st[0], st[1]); o.y = pk2(st[2], st[3]);
            *(uint2*)(p + (size_t)c * 32768) = o;
            st[0] = st[0] * g128 + bflo(kv.x); st[1] = st[1] * g128 + bfhi(kv.x); st[2] = st[2] * g128 + bflo(kv.y); st[3] = st[3] * g128 + bfhi(kv.y);
        }
    }
}
__device__ __forceinline__ void dma_rows128(const bf16_t* gsrc, size_t gstride, LAS unsigned char* dst, int wid, int lane) {
    for (int ii = wid; ii < 32; ii += 8) {
        const int row = ii * 4 + (lane >> 4), cp = lane & 15, ch = cp ^ (row & 15);
        const bf16_t* src = gsrc + (size_t)row * gstride + ch * 8;
        __builtin_amdgcn_global_load_lds((const unsigned*)src, (LAS unsigned*)(dst + ii * 1024), 16, 0, 0);
    }
}
__device__ __forceinline__ void ph_ret_out(const bf16_t* __restrict__ qr, const bf16_t* __restrict__ kr, const bf16_t* __restrict__ vr, const bf16_t* __restrict__ ST,
                                           const bf16_t* __restrict__ gsw, bf16_t* __restrict__ oret, LAS unsigned char* lds) {
    const int tid_ = fresh_tid(); const int lane0 = tid_ & 63, w = __builtin_amdgcn_readfirstlane(tid_ >> 6);
    LAS unsigned char* qimg = lds; LAS unsigned char* kimg = lds + 32768; LAS unsigned char* vimg = lds + 65536; LAS float* red = (LAS float*)(lds + 32768);
    const float ksc = 0.08838834764831845f;
    for (int unit = blockIdx.x; unit < 512; unit += gridDim.x) {
        const int b = unit >> 7, h = (unit >> 5) & 3, c = unit & 31;
        const size_t tok0 = (size_t)b * SEQ + c * 128;
        const float lg = ret_log2gamma(h);
        int lane = lane0; asm volatile("" : "+v"(lane));
        const int c16 = lane & 15, g = lane >> 4;
        __syncthreads();
        dma_rows128(qr + tok0 * 512 + h * 128, 512, qimg, w, lane);
        dma_rows128(kr + tok0 * 512 + h * 128, 512, kimg, w, lane);
        dma_tile128<512>(vr + tok0 * 1024 + h * 256, 1024, vimg, w, lane);
        bf16x8 sf[2][4];
        {
            const bf16_t* stp = ST + (size_t)unit * 32768 + (size_t)(32 * w + c16) * 128 + 8 * g;
#pragma unroll
            for (int ks = 0; ks < 4; ++ks) { sf[0][ks] = *(const bf16x8*)(stp + 32 * ks); sf[1][ks] = *(const bf16x8*)(stp + 16 * 128 + 32 * ks); }
        }
        asm volatile("s_waitcnt vmcnt(0)" ::: "memory");
        __syncthreads();
        f32x4 acc[2][8];
#pragma unroll
        for (int i = 0; i < 2; ++i)
#pragma unroll
            for (int j = 0; j < 8; ++j) acc[i][j] = (f32x4){0.f, 0.f, 0.f, 0.f};
#pragma unroll
        for (int ks = 0; ks < 4; ++ks)
#pragma unroll
            for (int qt = 0; qt < 8; ++qt) {
                const bf16x8 qf2 = *(const LAS bf16x8*)(qimg + (16 * qt + c16) * 256 + (((4 * ks + g) ^ c16) << 4));
                acc[0][qt] = __builtin_amdgcn_mfma_f32_16x16x32_bf16(sf[0][ks], qf2, acc[0][qt], 0, 0, 0);
                acc[1][qt] = __builtin_amdgcn_mfma_f32_16x16x32_bf16(sf[1][ks], qf2, acc[1][qt], 0, 0, 0);
                if ((qt & 3) == 3) asm volatile("" ::: "memory");
            }
#pragma unroll
        for (int qt = 0; qt < 8; ++qt) {
            const float xi = __builtin_amdgcn_exp2f(lg * (float)(16 * qt + c16 + 1));
            acc[0][qt] = acc[0][qt] * xi; acc[1][qt] = acc[1][qt] * xi;
        }
        const int pp = (w < 4) ? w : 7 - w, qtA = 7 - pp, qtB = pp;
        bf16x8 qfA[4], qfB[4];
#pragma unroll
        for (int ks = 0; ks < 4; ++ks) {
            qfA[ks] = *(const LAS bf16x8*)(qimg + (16 * qtA + c16) * 256 + (((4 * ks + g) ^ c16) << 4));
            qfB[ks] = *(const LAS bf16x8*)(qimg + (16 * qtB + c16) * 256 + (((4 * ks + g) ^ c16) << 4));
        }
        asm volatile("s_waitcnt lgkmcnt(0)" ::: "memory");
        __syncthreads();
        auto p_cells = [&](int qt, int kt0, int kt1, const bf16x8* qf) {
#pragma unroll 1
            for (int kt = kt0; kt < kt1; ++kt) {
                u32x2 pw = {0u, 0u};
                if (kt <= qt) {
                    f32x4 s = {0.f, 0.f, 0.f, 0.f};
#pragma unroll
                    for (int ks = 0; ks < 4; ++ks) {
                        const bf16x8 kf = *(const LAS bf16x8*)(kimg + (16 * kt + c16) * 256 + (((4 * ks + g) ^ c16) << 4));
                        s = __builtin_amdgcn_mfma_f32_16x16x32_bf16(kf, qf[ks], s, 0, 0, 0);
                    }
                    float p[4];
#pragma unroll
                    for (int reg = 0; reg < 4; ++reg) {
                        const int dt = (16 * qt + c16) - (16 * kt + 4 * g + reg);
                        p[reg] = dt >= 0 ? s[reg] * ksc * __builtin_amdgcn_exp2f(lg * (float)dt) : 0.f;
                    }
                    pw.x = cvtpk_bf16(p[0], p[1]); pw.y = cvtpk_bf16(p[2], p[3]);
                }
                *(LAS u32x2*)(qimg + (16 * qt + c16) * 256 + (((2 * kt + (g >> 1)) ^ c16) << 4) + 8 * (g & 1)) = pw;
            }
        };
        if (w < 4) p_cells(qtA, 0, 5, qfA);
        else { p_cells(qtA, 5, 8, qfA); p_cells(qtB, 0, 8, qfB); }
        __syncthreads();
#pragma unroll
        for (int ks = 0; ks < 4; ++ks) {
            const bf16x8 vf0 = tr_frag_at<512>(vimg, tr_base<512>(2 * w, lane), ks), vf1 = tr_frag_at<512>(vimg, tr_base<512>(2 * w + 1, lane), ks);
#pragma unroll
            for (int qt = 2 * ks; qt < 8; ++qt) {
                const bf16x8 pf = *(const LAS bf16x8*)(qimg + (16 * qt + c16) * 256 + (((4 * ks + g) ^ c16) << 4));
                acc[0][qt] = __builtin_amdgcn_mfma_f32_16x16x32_bf16(vf0, pf, acc[0][qt], 0, 0, 0);
                acc[1][qt] = __builtin_amdgcn_mfma_f32_16x16x32_bf16(vf1, pf, acc[1][qt], 0, 0, 0);
                if ((qt & 3) == 3) asm volatile("" ::: "memory");
            }
        }
#pragma unroll
        for (int qt = 0; qt < 8; ++qt) {
            float s1 = 0.f, s2 = 0.f;
#pragma unroll
            for (int dvt = 0; dvt < 2; ++dvt)
#pragma unroll
                for (int reg = 0; reg < 4; ++reg) { const float v = acc[dvt][qt][reg]; s1 += v; s2 += v * v; }
            s1 += __shfl_xor(s1, 16); s1 += __shfl_xor(s1, 32);
            s2 += __shfl_xor(s2, 16); s2 += __shfl_xor(s2, 32);
            if (g == 0) { red[(w * 128 + 16 * qt + c16) * 2] = s1; red[(w * 128 + 16 * qt + c16) * 2 + 1] = s2; }
        }
        __syncthreads();
#pragma unroll
        for (int qt = 0; qt < 8; ++qt) {
            float t1 = 0.f, t2 = 0.f;
#pragma unroll
            for (int ww = 0; ww < 8; ++ww) { t1 += red[(ww * 128 + 16 * qt + c16) * 2]; t2 += red[(ww * 128 + 16 * qt + c16) * 2 + 1]; }
            const float mu = t1 * (1.0f / 256.0f);
            const float var = fmaxf(t2 * (1.0f / 256.0f) - mu * mu, 0.f);
            const float r = rsqrtf(var + 1e-6f);
            const size_t rowoff = (tok0 + 16 * qt + c16) * 1024 + h * 256 + 32 * w + 4 * g;
#pragma unroll
            for (int dvt = 0; dvt < 2; ++dvt) {
                const uint2 gs = *(const uint2*)(gsw + rowoff + 16 * dvt);
                const float g0 = bflo(gs.x), g1 = bfhi(gs.x), g2 = bflo(gs.y), g3 = bfhi(gs.y);
                const f32x4 v = acc[dvt][qt];
                uint2 o;
                o.x = pk2(g0 * sigmoidf_fast(g0) * (v[0] - mu) * r, g1 * sigmoidf_fast(g1) * (v[1] - mu) * r);
                o.y = pk2(g2 * sigmoidf_fast(g2) * (v[2] - mu) * r, g3 * sigmoidf_fast(g3) * (v[3] - mu) * r);
                *(uint2*)(oret + rowoff + 16 * dvt) = o;
            }
            asm volatile("" ::: "memory");
        }
    }
}

__device__ __forceinline__ void ph_route(const Params& p, const float* __restrict__ x1, char* route, LAS unsigned char* lds) {
    LAS float* logits = (LAS float*)lds;
    LAS int* sel_e = (LAS int*)(lds + 12288);
    LAS float* sel_w = (LAS float*)(lds + 12288 + 512);
    const int t = fresh_tid(), wid = t >> 6, lane = t & 63, c = lane & 15, q = lane >> 4;
    int* wgcnt = (int*)(route + R_WGCNT); int* tok_e = (int*)(route + R_TOKE); int* tok_rank = (int*)(route + R_TOKRANK);
    float* tok_w = (float*)(route + R_TOKW); float* rstd_o = (float*)(route + R_RSTD);
    for (int grp = blockIdx.x; grp < NTOK / 64; grp += gridDim.x) {
        const int tok0 = grp * 64;
        __syncthreads();
        {
            const int tile = wid & 3, kb = (wid >> 2) * 512;
            const int tok = tok0 + tile * 16 + c;
            f32x4 a0 = {0.f, 0.f, 0.f, 0.f}, a1 = a0, a2 = a0; float ssq = 0.f;
            const float* xr = x1 + (size_t)tok * DM + kb + 4 * q;
            LAS unsigned char* Wl = lds + 32768;
            float4 xn[8];
#pragma unroll
            for (int j = 0; j < 8; ++j) xn[j] = *(const float4*)(xr + 16 * j);
#pragma unroll 1
            for (int stage = 0; stage < 2; ++stage) {
                __syncthreads();
#pragma unroll 3
                for (int r = 0; r < 9; ++r) {
                    const int id = t + 512 * r, j = id % 9, kk = id / 9, hh = kk >> 8, kl = kk & 255, k = hh * 512 + stage * 256 + kl;
                    const float4 v = (j < 8) ? *(const float4*)(p.w_er + k * 32 + 4 * j) : *(const float4*)(p.w_gr + k * 4);
                    const float gk = p.g_ffn[k];
                    LAS float* d = (LAS float*)(Wl + hh * 49152 + (kl >> 2) * 768 + j * 64 + (kl & 3) * 4);
                    d[0] = v.x * gk; d[4] = v.y * gk; d[8] = v.z * gk; d[12] = v.w * gk;
                }
                __syncthreads();
                const LAS unsigned char* wl = Wl + (wid >> 2) * 49152 + q * 768 + c * 16;
#pragma unroll 1
                for (int h8 = 0; h8 < 2; ++h8) {
                    const int it0 = stage * 16 + h8 * 8;
#pragma unroll
                    for (int j = 0; j < 8; ++j) {
                        const float4 xa = xn[j];
                        if (it0 + 8 < 32) xn[j] = *(const float4*)(xr + 16 * (it0 + 8 + j));
                        ssq += xa.x * xa.x + xa.y * xa.y + xa.z * xa.z + xa.w * xa.w;
                        const float av[4] = {xa.x, xa.y, xa.z, xa.w};
                        const LAS unsigned char* wr = wl + (h8 * 8 + j) * 4 * 768;
                        const f32x4 w0 = *(const LAS f32x4*)(wr), w1 = *(const LAS f32x4*)(wr + 256), w2r = *(const LAS f32x4*)(wr + 512);
                        const f32x4 w2 = (c < 4) ? w2r : (f32x4){0.f, 0.f, 0.f, 0.f};
#pragma unroll
                        for (int i = 0; i < 4; ++i) {
                            a0 = __builtin_amdgcn_mfma_f32_16x16x4f32(av[i], w0[i], a0, 0, 0, 0);
                            a1 = __builtin_amdgcn_mfma_f32_16x16x4f32(av[i], w1[i], a1, 0, 0, 0);
                            a2 = __builtin_amdgcn_mfma_f32_16x16x4f32(av[i], w2[i], a2, 0, 0, 0);
                        }
                        asm volatile("" ::: "memory");
                    }
                }
            }
            ssq += __shfl_xor(ssq, 16); ssq += __shfl_xor(ssq, 32);
            LAS float* park = (LAS float*)(lds + 16384) + (tile * 64 + lane) * 13;
            if (wid >= 4) {
#pragma unroll
                for (int r = 0; r < 4; ++r) { park[r] = a0[r]; park[4 + r] = a1[r]; park[8 + r] = a2[r]; }
                park[12] = ssq;
            }
            __syncthreads();
            if (wid < 4) {
#pragma unroll
                for (int r = 0; r < 4; ++r) { a0[r] += park[r]; a1[r] += park[4 + r]; a2[r] += park[8 + r]; }
                ssq += park[12];
                const float rstd = rsqrtf(ssq * (1.0f / DM) + 1e-6f);
                if (q == 0) rstd_o[tok] = rstd;
                const float be0 = p.b_er[c], be1 = p.b_er[16 + c], bg = (c < 4) ? p.b_gr[c] : 0.f;
#pragma unroll
                for (int reg = 0; reg < 4; ++reg) {
                    const int r = 4 * q + reg;
                    const float rs = __shfl(rstd, r);
                    LAS float* lp = logits + (tile * 16 + r) * 48;
                    lp[c] = a0[reg] * rs + be0; lp[16 + c] = a1[reg] * rs + be1;
                    if (c < 4) lp[32 + c] = a2[reg] * rs + bg;
                }
            }
        }
        __syncthreads();
        if (t < 64) {
            const LAS float* lp = logits + t * 48;
            int gi = 0; float mx = lp[32];
            for (int j = 1; j < 4; ++j) if (lp[32 + j] > mx) { mx = lp[32 + j]; gi = j; }
            float sum = 0.f;
            for (int j = 0; j < 4; ++j) sum += __expf(lp[32 + j] - mx);
            const float gval = 1.0f / sum;
            const LAS float* el = lp + gi * 8;
            int i1 = 0; float v1 = el[0];
            for (int j = 1; j < 8; ++j) if (el[j] > v1) { v1 = el[j]; i1 = j; }
            int i2 = 0; float v2 = -3.0e38f;
            for (int j = 0; j < 8; ++j) if (j != i1 && el[j] > v2) { v2 = el[j]; i2 = j; }
            const float e2 = __expf(v2 - v1);
            sel_e[2 * t] = gi * 8 + i1; sel_e[2 * t + 1] = gi * 8 + i2;
            sel_w[2 * t] = gval / (1.0f + e2); sel_w[2 * t + 1] = gval * e2 / (1.0f + e2);
        }
        __syncthreads();
        if (t < 128) {
            const int e = sel_e[t]; int rank = 0;
            for (int j = 0; j < t; ++j) rank += (sel_e[j] == e) ? 1 : 0;
            tok_e[tok0 * 2 + t] = e; tok_rank[tok0 * 2 + t] = rank; tok_w[tok0 * 2 + t] = sel_w[t];
        } else if (t < 160) {
            const int e = t - 128; int cnt = 0;
            for (int j = 0; j < 128; ++j) cnt += (sel_e[j] == e) ? 1 : 0;
            wgcnt[grp * 32 + e] = cnt;
        }
    }
}
__device__ __forceinline__ void moe_tables(const char* route, LAS unsigned char* lds, int grp) {
    LAS int* tstart = (LAS int*)(lds + LDS_MOE); LAS int* tot = tstart + 64; LAS int* bef = tstart + 128; LAS int* part = (LAS int*)(lds + 16384);
    const int* wgcnt = (const int*)(route + R_WGCNT);
    const int t = fresh_tid(), e = t & 31, pt = t >> 5;
    int s = 0, sb = 0;
#pragma unroll
    for (int j = 0; j < 16; ++j) { const int g = pt * 16 + j; const int v = wgcnt[g * 32 + e]; s += v; sb += (g < grp) ? v : 0; }
    part[pt * 32 + e] = s; part[512 + pt * 32 + e] = sb;
    __syncthreads();
    if (t < 32) { int a = 0, b = 0; for (int j = 0; j < 16; ++j) { a += part[j * 32 + t]; b += part[512 + j * 32 + t]; } tot[t] = a; bef[t] = b; }
    __syncthreads();
    if (t == 0) { int acc = 0; for (int k = 0; k < 32; ++k) { tstart[k] = acc; acc += (tot[k] + 255) >> 8; } tstart[32] = acc; }
    __syncthreads();
}
__device__ __forceinline__ void ph_gather(const Params& p, const float* __restrict__ x1, char* route, bf16_t* xs, LAS unsigned char* lds) {
    LAS int* tstart = (LAS int*)(lds + LDS_MOE); LAS int* bef = tstart + 128;
    const int* wgcnt = (const int*)(route + R_WGCNT); const int* tok_e = (const int*)(route + R_TOKE); const int* tok_rank = (const int*)(route + R_TOKRANK);
    const float* tok_w = (const float*)(route + R_TOKW); const float* rstd_i = (const float*)(route + R_RSTD);
    int* slot_tok = (int*)(route + R_SLOTTOK); float* slot_w = (float*)(route + R_SLOTW);
    const int t = fresh_tid(), wid = t >> 6, lane = t & 63;
    if ((int)blockIdx.x >= NTOK / 64) moe_tables(route, lds, 0);
    for (int grp = blockIdx.x; grp < NTOK / 64; grp += gridDim.x) {
        __syncthreads();
        moe_tables(route, lds, grp);
        for (int j = wid; j < 128; j += 8) {
            const int tok = grp * 64 + (j >> 1), ch = j & 1;
            const int e = tok_e[tok * 2 + ch];
            const int slot = tstart[e] * 256 + bef[e] + tok_rank[tok * 2 + ch];
            const float rs = rstd_i[tok];
#pragma unroll
            for (int jj = 0; jj < 4; ++jj) {
                const float4 v = ((const float4*)(x1 + (size_t)tok * DM))[lane + 64 * jj];
                const float4 gg = ((const float4*)p.g_ffn)[lane + 64 * jj];
                uint2 o; o.x = pk2(v.x * rs * gg.x, v.y * rs * gg.y); o.y = pk2(v.z * rs * gg.z, v.w * rs * gg.w);
                ((uint2*)(xs + (size_t)slot * DM))[lane + 64 * jj] = o;
            }
            if (lane == 0) { slot_tok[slot] = ch * NTOK + tok; slot_w[slot] = tok_w[tok * 2 + ch]; }
        }
    }
}
struct MoeOrder {
    const LAS int* tstart; int G, c, nunits;
    __device__ __forceinline__ bool next(int i, pg8::Unit& u) const {
        const long L = (long)i * G + c; if (L >= nunits) return false;
        const int T = (int)(L >> 2), nt = (int)(L & 3); int e = 0;
        for (int j = 1; j < 32; ++j) e += (tstart[j] <= T) ? 1 : 0;
        u.pm = T; u.pn = e * 4 + nt; return true;
    }
    __device__ __forceinline__ void a_ready(const pg8::Unit&) const {}
    __device__ __forceinline__ void done(const pg8::Unit&) const {}
};
struct EpiMoe1 {
    static constexpr bool PERM = true, AFTER_DRAIN = false;
    bf16_t* hid; const float* slot_w;
    __device__ __forceinline__ void operator()(const f32x4 (&acc)[2][2][4][2], const pg8::Unit& u, int wr, int wc, int fr, int fq) const {
        const int row0 = u.pm * 256 + wr * 64 + fr, f0 = (u.pn & 3) * 128 + wc * 16 + 4 * fq;
#pragma unroll
        for (int ai = 0; ai < 2; ++ai)
#pragma unroll
            for (int m = 0; m < 4; ++m) {
                const int row = row0 + ai * 128 + m * 16;
                const float w = slot_w[row];
#pragma unroll
                for (int bj = 0; bj < 2; ++bj) {
                    const f32x4 g = acc[ai][bj][m][0], up = acc[ai][bj][m][1];
                    float o[4];
#pragma unroll
                    for (int i = 0; i < 4; ++i) o[i] = g[i] * sigmoidf_fast(g[i]) * up[i] * w;
                    uint2 pk; pk.x = pk2(o[0], o[1]); pk.y = pk2(o[2], o[3]);
                    *(uint2*)(hid + (size_t)row * 512 + f0 + bj * 64) = pk;
                }
            }
    }
};
struct EpiMoe2 {
    static constexpr bool PERM = true, AFTER_DRAIN = false;
    bf16_t* y01; const int* slot_tok; const LAS int* tstart; const LAS int* tot;
    __device__ __forceinline__ void operator()(const f32x4 (&acc)[2][2][4][2], const pg8::Unit& u, int wr, int wc, int fr, int fq) const {
        const int e = u.pn >> 2, nvalid = tot[e] - (u.pm - tstart[e]) * 256;
        const int lrow0 = wr * 64 + fr, col0 = (u.pn & 3) * 256 + wc * 32 + 8 * fq;
#pragma unroll
        for (int ai = 0; ai < 2; ++ai)
#pragma unroll
            for (int m = 0; m < 4; ++m) {
                const int lrow = lrow0 + ai * 128 + m * 16;
                if (lrow < nvalid) {
                    const int dst = slot_tok[u.pm * 256 + lrow];
                    bf16_t* rowp = y01 + (size_t)dst * 1024 + col0;
#pragma unroll
                    for (int bj = 0; bj < 2; ++bj) {
                        const f32x4 v0 = acc[ai][bj][m][0], v1 = acc[ai][bj][m][1];
                        u32x4 o; o.x = pk2(v0[0], v0[1]); o.y = pk2(v0[2], v0[3]); o.z = pk2(v1[0], v1[1]); o.w = pk2(v1[2], v1[3]);
                        *(u32x4*)(rowp + bj * 128) = o;
                    }
                }
            }
    }
};
__device__ __forceinline__ void ph_final(const float* __restrict__ x1, const bf16_t* __restrict__ y01, const float* __restrict__ g, float* __restrict__ out) {
    const int tid_ = fresh_tid(); const int lane = tid_ & 63, gw = blockIdx.x * 8 + (tid_ >> 6), ngw = gridDim.x * 8;
    for (int row = gw; row < NTOK; row += ngw) {
        float4 v[4]; float ss = 0.f;
#pragma unroll
        for (int j = 0; j < 4; ++j) {
            v[j] = ((const float4*)(x1 + (size_t)row * DM))[lane + 64 * j];
            const uint2 a = ((const uint2*)(y01 + (size_t)row * DM))[lane + 64 * j];
            const uint2 b = ((const uint2*)(y01 + (size_t)(NTOK + row) * DM))[lane + 64 * j];
            v[j].x += bflo(a.x) + bflo(b.x); v[j].y += bfhi(a.x) + bfhi(b.x); v[j].z += bflo(a.y) + bflo(b.y); v[j].w += bfhi(a.y) + bfhi(b.y);
            ss += v[j].x * v[j].x + v[j].y * v[j].y + v[j].z * v[j].z + v[j].w * v[j].w;
        }
        ss = wave_sum(ss);
        const float r = rsqrtf(ss * (1.0f / DM) + 1e-6f);
#pragma unroll
        for (int j = 0; j < 4; ++j) {
            const float4 gg = ((const float4*)g)[lane + 64 * j];
            float4 o; o.x = v[j].x * r * gg.x; o.y = v[j].y * r * gg.y; o.z = v[j].z * r * gg.z; o.w = v[j].w * r * gg.w;
            ((float4*)(out + (size_t)row * DM))[lane + 64 * j] = o;
        }
    }
}

__global__ void __launch_bounds__(NTHR, 2) fwd_megakernel(Params p) {
    extern __shared__ __attribute__((aligned(16))) unsigned char lds_raw[];
    LAS unsigned char* lds = (LAS unsigned char*)lds_raw;
    char* ws = p.ws; char* ob = p.ob;
    bf16_t* WinT = (bf16_t*)(ws + WS_WINT * MiB);
    bf16_t* PAt = (bf16_t*)(ws + WS_PAT * MiB);
    bf16_t* PRt = (bf16_t*)(ws + WS_PRT * MiB);
    bf16_t* WoT = (bf16_t*)(ws + WS_WOT * MiB);
    bf16_t* qa = (bf16_t*)(ws + WS_QA * MiB);
    bf16_t* ka = (bf16_t*)(ws + WS_KA * MiB);
    bf16_t* va = (bf16_t*)(ws + WS_VA * MiB);
    bf16_t* qr = (bf16_t*)(ws + WS_QR * MiB);
    bf16_t* kr = (bf16_t*)(ws + WS_KR * MiB);
    bf16_t* vr = (bf16_t*)(ws + WS_VR * MiB);
    bf16_t* gsw = (bf16_t*)(ws + WS_GSW * MiB);
    bf16_t* ga = (bf16_t*)(ws + WS_GA * MiB);
    bf16_t* oattn = (bf16_t*)(ws + WS_OATTN * MiB);
    bf16_t* hb = (bf16_t*)(ob + 0 * MiB);
    bf16_t* gr = (bf16_t*)(ob + 32 * MiB);
    bf16_t* oret = (bf16_t*)(ws + WS_ORET * MiB);
    bf16_t* merged = (bf16_t*)(ws + WS_MERGED * MiB);
    float* x1 = (float*)(ws + WS_X1 * MiB);
    const int G = gridDim.x;
    if (threadIdx.x < 4) ((LAS unsigned*)(lds + LDS_BARST))[threadIdx.x] = 0u;
    __syncthreads();
    XcdBarrier bar = xcd_barrier_post((unsigned*)(ws + WS_CTL * MiB), (volatile LAS unsigned*)(lds + LDS_BARST));

    char* route = ws + WS_ROUTE * MiB;
    bf16_t* WguT = (bf16_t*)(ws + WS_WGU * MiB);
    bf16_t* WdT = (bf16_t*)(ws + WS_WD * MiB);
    bf16_t* xs = (bf16_t*)(ws + WS_XS * MiB);
    bf16_t* y01 = (bf16_t*)(ws + WS_Y01 * MiB);
    bf16_t* hid = (bf16_t*)(ob);
    bf16_t* KS = (bf16_t*)(ob);
    ph_transpose_all(p.w_in, 1024, 9728, 1, WinT, lds);
    ph_transpose_all(p.w_ab, 512, 1024, 1, PAt, lds);
    ph_transpose_all(p.w_rb, 1024, 1024, 1, PRt, lds);
    ph_transpose_all(p.w_out, 1024, 1024, 1, WoT, lds);
    ph_rmsnorm_bf16(p.x, p.g_mix, hb);
    xcd_barrier(bar);
    {
        pg8::Gemm g{hb, WinT, NTOK, 9728, 1024}; pg8::StaticOrder S; S.init(NTOK, 9728, G, (int)blockIdx.x);
        EpiProj E{ws, ob};
        pg8::gemm_phase<EpiProj, pg8::StaticOrder, true, true>(lds, g, S, E);
    }
    xcd_barrier(bar);
    ph_attn(qa, ka, va, oattn, lds);
    ph_ret_kv(kr, vr, KS, lds);
    xcd_barrier(bar);
    ph_ret_scan(KS);
    if (blockIdx.x & 1) { ph_transpose_gu(p.w_gate, p.w_up, WguT, lds); __syncthreads(); }
    {
        pg8::Gemm g{oattn, PAt, NTOK, 1024, 512}; pg8::StaticOrder S; S.init(NTOK, 1024, G, (int)blockIdx.x);
        EpiGate E{ga, merged, 0};
        pg8::gemm_phase<EpiGate, pg8::StaticOrder, true, true>(lds, g, S, E);
    }
    if (!(blockIdx.x & 1)) ph_transpose_gu(p.w_gate, p.w_up, WguT, lds);
    xcd_barrier(bar);
    ph_ret_out(qr, kr, vr, KS, gsw, oret, lds);
    xcd_barrier(bar);
    {
        pg8::Gemm g{oret, PRt, NTOK, 1024, 1024}; pg8::StaticOrder S; S.init(NTOK, 1024, G, (int)blockIdx.x);
        EpiGate E{gr, merged, 1};
        pg8::gemm_phase<EpiGate, pg8::StaticOrder, true, true>(lds, g, S, E);
    }
    xcd_barrier(bar);
    if (blockIdx.x & 1) { ph_transpose_all(p.w_down, 512, 1024, 32, WdT, lds); __syncthreads(); }
    {
        pg8::Gemm g{merged, WoT, NTOK, 1024, 1024}; pg8::StaticOrder S; S.init(NTOK, 1024, G, (int)blockIdx.x);
        EpiResid E{p.x, x1};
        pg8::gemm_phase<EpiResid, pg8::StaticOrder, true, true>(lds, g, S, E);
    }
    if (!(blockIdx.x & 1)) ph_transpose_all(p.w_down, 512, 1024, 32, WdT, lds);
    xcd_barrier(bar);
    ph_route(p, x1, route, lds);
    xcd_barrier(bar);
    ph_gather(p, x1, route, xs, lds);
    xcd_barrier(bar);
    const LAS int* tstart = (const LAS int*)(lds + LDS_MOE); const LAS int* tot = tstart + 64;
    {
        pg8::Gemm g{xs, WguT, 40960, 32 * 1024, 1024}; MoeOrder S{tstart, G, (int)blockIdx.x, tstart[32] * 4};
        EpiMoe1 E{hid, (const float*)(route + R_SLOTW)};
        pg8::gemm_phase<EpiMoe1, MoeOrder, true, true>(lds, g, S, E);
    }
    xcd_barrier(bar);
    {
        pg8::Gemm g{hid, WdT, 40960, 32 * 1024, 512}; MoeOrder S{tstart, G, (int)blockIdx.x, tstart[32] * 4};
        EpiMoe2 E{y01, (const int*)(route + R_SLOTTOK), tstart, tot};
        pg8::gemm_phase<EpiMoe2, MoeOrder, true, true>(lds, g, S, E);
    }
    xcd_barrier(bar);
    ph_final(x1, y01, p.g_final, p.out);
}

extern "C" void kernel_launch(void* const* d_in, const int* in_sizes, int n_in, void* d_out, int out_size, void* d_ws, size_t ws_size, hipStream_t stream) {
    static int grid_blocks = 0;
    if (!grid_blocks) {
        int dev = 0, cus = 0, per_cu = 0;
        (void)hipGetDevice(&dev);
        (void)hipDeviceGetAttribute(&cus, hipDeviceAttributeMultiprocessorCount, dev);
        (void)hipFuncSetAttribute((const void*)fwd_megakernel, hipFuncAttributeMaxDynamicSharedMemorySize, LDS_BYTES);
        (void)hipOccupancyMaxActiveBlocksPerMultiprocessor(&per_cu, (const void*)fwd_megakernel, NTHR, LDS_BYTES);
        if (per_cu > 1) per_cu = 1;
        grid_blocks = cus * per_cu;
        if (grid_blocks <= 0 || ws_size < WS_END * MiB) { fprintf(stderr, "kernel_launch: cannot launch (grid %d, ws %zu)\n", grid_blocks, ws_size); grid_blocks = -1; }
    }
    if (grid_blocks < 0) return;
    Params p{};
    p.x = (const float*)d_in[0]; p.g_mix = (const float*)d_in[1]; p.w_in = (const float*)d_in[2]; p.w_ab = (const float*)d_in[3];
    p.w_rb = (const float*)d_in[4]; p.w_out = (const float*)d_in[5]; p.g_ffn = (const float*)d_in[6]; p.w_gr = (const float*)d_in[7];
    p.b_gr = (const float*)d_in[8]; p.w_er = (const float*)d_in[9]; p.b_er = (const float*)d_in[10]; p.w_gate = (const float*)d_in[11];
    p.w_up = (const float*)d_in[12]; p.w_down = (const float*)d_in[13]; p.g_final = (const float*)d_in[14];
    p.out = (float*)d_out; p.ws = (char*)d_ws; p.ob = (char*)d_out;
    (void)hipMemsetAsync(d_ws, 0, CTL_ZERO_BYTES, stream);
    void* args[] = {&p};
    hipError_t e = hipLaunchCooperativeKernel((const void*)fwd_megakernel, dim3(grid_blocks), dim3(NTHR), args, LDS_BYTES, stream);
    if (e != hipSuccess) fprintf(stderr, "cooperative launch failed: %s (grid %d)\n", hipGetErrorString(e), grid_blocks);
}
```
